# Optimizing an MI355X kernel written in HIP

```python
import jax, jax.numpy as jnp
from jax import lax
import numpy as np

D_MODEL = 1024
BATCH = 16
SEQ = 2048
DEPTH = 1

N_META = 16
N_HEADS = 16
HEAD_DIM = 64
D_ATTN = N_HEADS * HEAD_DIM
D_CONV = D_MODEL
CONV_WIDTH = 31
D_FF = 4 * D_MODEL
Q_BLOCK = 128
RMS_EPS = 1e-6
LN_EPS = 1e-5

PART_SIZES = [D_ATTN, D_ATTN, D_ATTN, N_HEADS, 2 * D_CONV, D_MODEL, D_MODEL]
PART_OFFSETS = [int(o) for o in np.cumsum([0] + PART_SIZES)]
N_IN = PART_OFFSETS[-1]

kernel_name = "fox_conformer_parallel_gated_hybrid"


def rms_norm(x, g):
    xf = x.astype(jnp.float32)
    y = xf * lax.rsqrt(jnp.mean(xf * xf, axis=-1, keepdims=True) + RMS_EPS)
    return (y * g.astype(jnp.float32)).astype(x.dtype)


def layer_norm(x, g, b):
    xf = x.astype(jnp.float32)
    mu = jnp.mean(xf, axis=-1, keepdims=True)
    xc = xf - mu
    var = jnp.mean(xc * xc, axis=-1, keepdims=True)
    y = xc * lax.rsqrt(var + LN_EPS) * g.astype(jnp.float32) + b.astype(jnp.float32)
    return y.astype(x.dtype)


def forgetting_attention(q, k, v, fg_logit):
    T = q.shape[1]
    scale = HEAD_DIM ** -0.5
    log_f = jax.nn.log_sigmoid(fg_logit.astype(jnp.float32))
    cum = jnp.transpose(jnp.cumsum(log_f, axis=1), (0, 2, 1))
    starts = [0] + list(range(N_META, T, Q_BLOCK))
    ends = starts[1:] + [T]
    outs = []
    for q0, q1 in zip(starts, ends):
        s = jnp.einsum('bqhd,bkhd->bhqk', q[:, q0:q1], k[:, :q1]).astype(jnp.float32) * scale
        s = s + cum[:, :, q0:q1, None] - cum[:, :, None, :q1]
        causal = jnp.arange(q0, q1)[:, None] >= jnp.arange(q1)[None, :]
        s = jnp.where(causal, s, -jnp.inf)
        p = jax.nn.softmax(s, axis=-1).astype(v.dtype)
        outs.append(jnp.einsum('bhqk,bkhd->bqhd', p, v[:, :q1]))
    return jnp.concatenate(outs, axis=1)


def causal_depthwise_conv(u, w, b):
    C = u.shape[-1]
    y = lax.conv_general_dilated(
        u, w[:, None, :].astype(u.dtype), window_strides=(1,),
        padding=((CONV_WIDTH - 1, 0),), dimension_numbers=('NWC', 'WIO', 'NWC'),
        feature_group_count=C)
    return y + b.astype(u.dtype)


def setup_inputs(seed: int = 0) -> dict:
    key = jax.random.key(seed)
    ks = jax.random.split(key, 20)
    nrm = lambda k, shape, fan_in: jax.random.normal(k, shape, jnp.float32) * (fan_in ** -0.5)
    gain = lambda k, shape: 1.0 + 0.02 * jax.random.normal(k, shape, jnp.float32)
    small = lambda k, shape: 0.02 * jax.random.normal(k, shape, jnp.float32)
    return {
        "x": jax.random.normal(ks[0], (BATCH, SEQ, D_MODEL), jnp.float32),
        "meta_tokens": jax.random.normal(ks[1], (N_META, D_MODEL), jnp.float32),
        "norm_mix_gain": gain(ks[2], (DEPTH, D_MODEL)),
        "w_in": nrm(ks[3], (DEPTH, D_MODEL, N_IN), D_MODEL),
        "b_forget": jax.random.uniform(ks[4], (DEPTH, N_HEADS), jnp.float32, 1.0, 6.0),
        "w_attn_out": nrm(ks[5], (DEPTH, D_ATTN, D_MODEL), D_ATTN),
        "b_glu": small(ks[6], (DEPTH, 2 * D_CONV)),
        "conv_dw_w": nrm(ks[7], (DEPTH, CONV_WIDTH, D_CONV), CONV_WIDTH),
        "conv_dw_b": small(ks[8], (DEPTH, D_CONV)),
        "conv_ln_gain": gain(ks[9], (DEPTH, D_CONV)),
        "conv_ln_bias": small(ks[10], (DEPTH, D_CONV)),
        "w_conv_out": nrm(ks[11], (DEPTH, D_CONV, D_MODEL), D_CONV),
        "b_conv_out": small(ks[12], (DEPTH, D_MODEL)),
        "w_out": nrm(ks[13], (DEPTH, D_MODEL, D_MODEL), D_MODEL),
        "norm_mlp_gain": gain(ks[14], (DEPTH, D_MODEL)),
        "w_mlp_up": nrm(ks[15], (DEPTH, D_MODEL, D_FF), D_MODEL),
        "w_mlp_down": nrm(ks[16], (DEPTH, D_FF, D_MODEL), D_FF),
        "final_norm_gain": gain(ks[17], (D_MODEL,)),
    }


def reference(x, meta_tokens, norm_mix_gain, w_in, b_forget, w_attn_out, b_glu,
              conv_dw_w, conv_dw_b, conv_ln_gain, conv_ln_bias, w_conv_out, b_conv_out,
              w_out, norm_mlp_gain, w_mlp_up, w_mlp_down, final_norm_gain):
    B = x.shape[0]
    meta = jnp.broadcast_to(meta_tokens[None].astype(x.dtype), (B, N_META, D_MODEL))
    h_res = jnp.concatenate([meta, x], axis=1)
    T = h_res.shape[1]
    o = PART_OFFSETS
    for l in range(DEPTH):
        hn = rms_norm(h_res, norm_mix_gain[l])
        w_l = w_in[l]
        part = lambda i: hn @ w_l[:, o[i]:o[i + 1]]
        q = part(0).reshape(B, T, N_HEADS, HEAD_DIM)
        k = part(1).reshape(B, T, N_HEADS, HEAD_DIM)
        v = part(2).reshape(B, T, N_HEADS, HEAD_DIM)
        fg = part(3) + b_forget[l]
        glu_in = part(4) + b_glu[l]
        gate_attn = jax.nn.sigmoid(part(5))
        gate_conv = jax.nn.sigmoid(part(6))

        a = forgetting_attention(q, k, v, fg).reshape(B, T, D_ATTN) @ w_attn_out[l]

        u = glu_in[..., :D_CONV] * jax.nn.sigmoid(glu_in[..., D_CONV:])
        c = causal_depthwise_conv(u, conv_dw_w[l], conv_dw_b[l])
        c = jax.nn.silu(layer_norm(c, conv_ln_gain[l], conv_ln_bias[l]))
        c = c @ w_conv_out[l] + b_conv_out[l]

        h_res = h_res + (gate_attn * a + gate_conv * c) @ w_out[l]

        hn = rms_norm(h_res, norm_mlp_gain[l])
        h_res = h_res + jnp.square(jax.nn.relu(hn @ w_mlp_up[l])) @ w_mlp_down[l]
    y = rms_norm(h_res, final_norm_gain)
    return y[:, N_META:]
```

```cpp
#include <hip/hip_runtime.h>
#include <hip/hip_cooperative_groups.h>
#include <cstdio>
#include <cstdint>
namespace cg = cooperative_groups;
namespace pg8 {
#define PG8_LAS __attribute__((address_space(3)))
typedef unsigned short bf16_t;
typedef short bf16x8 __attribute__((ext_vector_type(8)));
typedef float f32x4 __attribute__((ext_vector_type(4)));
typedef unsigned u32x4 __attribute__((ext_vector_type(4)));
constexpr int BM = 256, BK = 64, HALF = 128, HTB = HALF * BK * 2  , STAGE_BYTES = 8 * HTB, NXCD = 8, WGM = 8;

__host__ __device__ __forceinline__ int lds_byte(int r, int c) { const int st = (r >> 4) * 2 + (c >> 5), rr = r & 15, cc = c & 31, ob = rr * 64 + cc * 2; return st * 1024 + (ob ^ (((ob >> 9) & 1) << 5)); }
__host__ __device__ __forceinline__ void stage_rc(int b, int& R, int& C) { const int st = b / 1024, sb = b % 1024, swz = sb ^ (((sb >> 9) & 1) << 5); R = (st >> 1) * 16 + swz / 64; C = (st & 1) * 32 + (swz % 64) / 2; }
__host__ __device__ __forceinline__ int perm32(int rho) { const int n = rho >> 4, i = rho & 15; return 8 * (i >> 2) + 4 * n + (i & 3); }

struct Unit { int pm, pn; };
struct Gemm { const bf16_t* A; const bf16_t* Bt; int M, N, K; };

struct StaticOrder {
    int nM, nN, nwg, G, c;
    __host__ __device__ void init(int M, int N, int G_, int c_) { nM = M / BM; nN = N / BM; nwg = nM * nN; G = G_; c = c_; }
    __host__ __device__ bool next(int i, Unit& u) const {
        const long L = (long)i * G + c; if (L >= nwg) return false;
        int wgid = (int)L; { const int q = nwg / NXCD, r = nwg % NXCD, xcd = wgid % NXCD, off = wgid / NXCD; wgid = (xcd < r ? xcd * (q + 1) : r * (q + 1) + (xcd - r) * q) + off; }
        const int nig = WGM * nN, gid = wgid / nig, fm = gid * WGM, gsz = (nM - fm) < WGM ? (nM - fm) : WGM;
        u.pm = fm + ((wgid % nig) % gsz); u.pn = (wgid % nig) / gsz; return true;
    }
    __device__ __forceinline__ void a_ready(const Unit&) const {}
    __device__ __forceinline__ void done(const Unit&) const {}
};

__device__ __forceinline__ unsigned cvt_pk_bf16(float lo, float hi) { unsigned r; asm volatile("v_cvt_pk_bf16_f32 %0, %1, %2" : "=v"(r) : "v"(lo), "v"(hi)); return r; }
typedef unsigned u32x2 __attribute__((ext_vector_type(2)));
__device__ __forceinline__ float sigmoid_f(float x) { return __builtin_amdgcn_rcpf(1.0f + __builtin_amdgcn_exp2f(-1.4426950408889634f * x)); }

struct GemmPlain { const bf16_t* A; const bf16_t* Bt; int K;
    __device__ __forceinline__ const char* a_ptr(const Unit& u) const { return (const char*)A + (size_t)u.pm * (size_t)(BM * 2) * K; }
    __device__ __forceinline__ const char* b_ptr(const Unit& u) const { return (const char*)Bt + (size_t)u.pn * (size_t)(BM * 2) * K; } };
struct GemmBranch { const bf16_t* A0; const bf16_t* A1; const bf16_t* B0; const bf16_t* B1; int K;
    __device__ __forceinline__ const char* a_ptr(const Unit& u) const { return (const char*)(u.pn < 4 ? A0 : A1) + (size_t)u.pm * (size_t)(BM * 2) * K; }
    __device__ __forceinline__ const char* b_ptr(const Unit& u) const { return (const char*)(u.pn < 4 ? B0 : B1) + (size_t)(u.pn & 3) * (size_t)(BM * 2) * K; } };

struct InProjOrder {
    StaticOrder so;
    __device__ void init(int M, int N, int G_, int c_) { so.init(M, N, G_, c_); }
    __device__ bool next(int i, Unit& u) const {
        const long L = (long)i * so.G + so.c;
        if (L < so.nwg) return so.next(i, u);
        const int e = (int)(L - so.nwg); if (e >= 16) return false;
        u.pm = so.nM; u.pn = 4 + e; return true;
    }
    __device__ __forceinline__ void a_ready(const Unit&) const {}
    __device__ __forceinline__ void done(const Unit&) const {}
};

struct EpiInProj {
    static constexpr bool PERM = true, AFTER_DRAIN = false;
    bf16_t *Q, *Kb, *Vb, *Ub, *GA, *GC; const float* bglu; float c2;
    __device__ __forceinline__ void operator()(const f32x4 (&acc)[2][2][4][2], const Unit& u, int wr, int wc, int fr, int fq) const {
        const int row0 = u.pm * BM + wr * 64 + fr; const int pn = u.pn;
        if (pn >= 12 && pn < 20) {
            const int ch0 = (pn - 12) * 128 + wc * 32 + 8 * fq;
            f32x4 ba[2], bb[2];
#pragma unroll
            for (int n = 0; n < 2; ++n) { ba[n] = *(const f32x4*)(bglu + ch0 + 4 * n); bb[n] = *(const f32x4*)(bglu + 1024 + ch0 + 4 * n); }
#pragma unroll
            for (int ai = 0; ai < 2; ++ai)
#pragma unroll
                for (int m = 0; m < 4; ++m) {
                    bf16_t* rowp = Ub + (size_t)(row0 + ai * HALF + m * 16) * 1024 + ch0;
                    float o[8];
#pragma unroll
                    for (int n = 0; n < 2; ++n)
#pragma unroll
                        for (int e = 0; e < 4; ++e) { const float a = acc[ai][0][m][n][e] + ba[n][e], b = acc[ai][1][m][n][e] + bb[n][e]; o[4 * n + e] = a * sigmoid_f(b); }
                    u32x4 w; w.x = cvt_pk_bf16(o[0], o[1]); w.y = cvt_pk_bf16(o[2], o[3]); w.z = cvt_pk_bf16(o[4], o[5]); w.w = cvt_pk_bf16(o[6], o[7]);
                    *(u32x4*)rowp = w;
                }
            return;
        }
        bf16_t* base; int colt; float sc = 1.f; bool sg = false;
        if (pn < 4) { base = Q; colt = pn * BM; sc = c2; }
        else if (pn < 8) { base = Kb; colt = (pn - 4) * BM; }
        else if (pn < 12) { base = Vb; colt = (pn - 8) * BM; }
        else if (pn < 24) { base = GA; colt = (pn - 20) * BM; sg = true; }
        else { base = GC; colt = (pn - 24) * BM; sg = true; }
        const int col0 = colt + wc * 32 + 8 * fq;
#pragma unroll
        for (int ai = 0; ai < 2; ++ai)
#pragma unroll
            for (int m = 0; m < 4; ++m) { bf16_t* rowp = base + (size_t)(row0 + ai * HALF + m * 16) * 1024 + col0;
#pragma unroll
                for (int bj = 0; bj < 2; ++bj) { f32x4 v0 = acc[ai][bj][m][0], v1 = acc[ai][bj][m][1];
                    if (sg) {
#pragma unroll
                        for (int e = 0; e < 4; ++e) { v0[e] = sigmoid_f(v0[e]); v1[e] = sigmoid_f(v1[e]); } }
                    else { v0 = v0 * sc; v1 = v1 * sc; }
                    u32x4 w; w.x = cvt_pk_bf16(v0[0], v0[1]); w.y = cvt_pk_bf16(v0[2], v0[3]); w.z = cvt_pk_bf16(v1[0], v1[1]); w.w = cvt_pk_bf16(v1[2], v1[3]);
                    *(u32x4*)(rowp + bj * HALF) = w; } }
    }
};

__device__ __forceinline__ float bf_lo(unsigned w) { return __uint_as_float(w << 16); }
__device__ __forceinline__ float bf_hi(unsigned w) { return __uint_as_float(w & 0xffff0000u); }

struct EpiBranch {
    static constexpr bool PERM = true, AFTER_DRAIN = false;
    bf16_t* MM; const bf16_t *GA, *GC; const float* bc;
    __device__ __forceinline__ void operator()(const f32x4 (&acc)[2][2][4][2], const Unit& u, int wr, int wc, int fr, int fq) const {
        const int row0 = u.pm * BM + wr * 64 + fr; const bool cv = u.pn >= 4;
        const bf16_t* G = cv ? GC : GA; const int gcol0 = (u.pn & 3) * BM + wc * 32 + 8 * fq; const int ocol0 = u.pn * BM + wc * 32 + 8 * fq;
        f32x4 bv[2][2];
#pragma unroll
        for (int bj = 0; bj < 2; ++bj)
#pragma unroll
            for (int n = 0; n < 2; ++n) bv[bj][n] = cv ? *(const f32x4*)(bc + gcol0 + bj * HALF + 4 * n) : (f32x4){0.f, 0.f, 0.f, 0.f};
#pragma unroll
        for (int ai = 0; ai < 2; ++ai)
#pragma unroll
            for (int m = 0; m < 4; ++m) { const size_t r = (size_t)(row0 + ai * HALF + m * 16);
#pragma unroll
                for (int bj = 0; bj < 2; ++bj) {
                    const u32x4 g = *(const u32x4*)(G + r * 1024 + gcol0 + bj * HALF);
                    const f32x4 v0 = acc[ai][bj][m][0] + bv[bj][0], v1 = acc[ai][bj][m][1] + bv[bj][1];
                    u32x4 w;
                    w.x = cvt_pk_bf16(v0[0] * bf_lo(g.x), v0[1] * bf_hi(g.x)); w.y = cvt_pk_bf16(v0[2] * bf_lo(g.y), v0[3] * bf_hi(g.y));
                    w.z = cvt_pk_bf16(v1[0] * bf_lo(g.z), v1[1] * bf_hi(g.z)); w.w = cvt_pk_bf16(v1[2] * bf_lo(g.w), v1[3] * bf_hi(g.w));
                    *(u32x4*)(MM + r * 2048 + ocol0 + bj * HALF) = w; } }
    }
};

template <bool WRITE_XN> struct EpiResid {
    static constexpr bool PERM = false, AFTER_DRAIN = false;
    const float* base; float* out; float* ss; bf16_t* XN; const float* gain;
    __device__ __forceinline__ void operator()(const f32x4 (&acc)[2][2][4][2], const Unit& u, int wr, int wc, int fr, int fq) const {
        const int col0 = u.pn * BM + wc * 32 + 4 * fq;
        f32x4 gv[2][2];
        if (WRITE_XN) {
#pragma unroll
            for (int bj = 0; bj < 2; ++bj)
#pragma unroll
                for (int n = 0; n < 2; ++n) gv[bj][n] = *(const f32x4*)(gain + col0 + bj * HALF + n * 16);
        }
#pragma unroll
        for (int ai = 0; ai < 2; ++ai)
#pragma unroll
            for (int m = 0; m < 4; ++m) { const int r = u.pm * BM + ai * HALF + wr * 64 + m * 16 + fr; const size_t off = (size_t)r * 1024 + col0; float sq = 0.f;
#pragma unroll
                for (int bj = 0; bj < 2; ++bj)
#pragma unroll
                    for (int n = 0; n < 2; ++n) { const size_t o = off + bj * HALF + n * 16; const f32x4 h = *(const f32x4*)(base + o) + acc[ai][bj][m][n];
                        *(f32x4*)(out + o) = h; sq += (h[0] * h[0] + h[1] * h[1]) + (h[2] * h[2] + h[3] * h[3]);
                        if (WRITE_XN) { const f32x4 y = h * gv[bj][n]; u32x2 w; w.x = cvt_pk_bf16(y[0], y[1]); w.y = cvt_pk_bf16(y[2], y[3]); *(u32x2*)(XN + o) = w; } }
                sq += __shfl_xor(sq, 16); sq += __shfl_xor(sq, 32);
                if (fq == 0) atomicAdd(ss + r, sq); }
    }
};

struct EpiUp {
    static constexpr bool PERM = true, AFTER_DRAIN = false;
    bf16_t* H; const float* ss; float eps;
    __device__ __forceinline__ void operator()(const f32x4 (&acc)[2][2][4][2], const Unit& u, int wr, int wc, int fr, int fq) const {
        const int row0 = u.pm * BM + wr * 64 + fr; const int col0 = u.pn * BM + wc * 32 + 8 * fq;
#pragma unroll
        for (int ai = 0; ai < 2; ++ai)
#pragma unroll
            for (int m = 0; m < 4; ++m) { const int r = row0 + ai * HALF + m * 16; const float r2 = 1.0f / (ss[r] * (1.0f / 1024.0f) + eps);
                bf16_t* rowp = H + (size_t)r * 4096 + col0;
#pragma unroll
                for (int bj = 0; bj < 2; ++bj) { f32x4 v0 = acc[ai][bj][m][0], v1 = acc[ai][bj][m][1];
#pragma unroll
                    for (int e = 0; e < 4; ++e) { const float a = fmaxf(v0[e], 0.f), b = fmaxf(v1[e], 0.f); v0[e] = a * a * r2; v1[e] = b * b * r2; }
                    u32x4 w; w.x = cvt_pk_bf16(v0[0], v0[1]); w.y = cvt_pk_bf16(v0[2], v0[3]); w.z = cvt_pk_bf16(v1[0], v1[1]); w.w = cvt_pk_bf16(v1[2], v1[3]);
                    *(u32x4*)(rowp + bj * HALF) = w; } }
    }
};

template <class Epi, class Sched, class GG, bool ALIGN_EPI = false, bool SP2 = false>
__device__ __forceinline__ void gemm_phase(PG8_LAS unsigned char* lds, const GG g, const Sched& S, const Epi& E) {
    int tid_ = threadIdx.x; asm volatile("" : "+v"(tid_));
    const int tid = tid_, wid = __builtin_amdgcn_readfirstlane(tid >> 6), lane = tid & 63, wr = wid >> 2, wc = wid & 3, fr = lane & 15, fq = lane >> 4;
    const int K = g.K, nt = K / BK;
    unsigned voffA[2], voffB[2];
#pragma unroll
    for (int i = 0; i < 2; ++i) { int R, C; stage_rc(tid * 16 + i * 8192, R, C); const int Rb = Epi::PERM ? ((R & ~31) + perm32(R & 31)) : R;
        voffA[i] = (unsigned)(R * K + C) * 2u; voffB[i] = (unsigned)(Rb * K + C) * 2u; }
    const size_t kstep = (size_t)(BK * 2);
    const size_t hstep = (size_t)HALF * K * 2;
    const unsigned ldsw = (unsigned)wid * 1024u;
    const int aoff = lds_byte(wr * 64 + fr, fq * 8), boff = lds_byte(wc * 32 + fr, fq * 8);
#define PG8_SA(b, h) (((b) * 2 + (h)) * HTB)
#define PG8_SB(b, h) ((4 + (b) * 2 + (h)) * HTB)
#define PG8_STAGE(bufoff, gbase, voff) do { _Pragma("unroll") for (int _i = 0; _i < 2; ++_i) \
        __builtin_amdgcn_global_load_lds((const unsigned*)((const char*)(gbase) + (voff)[_i]), (PG8_LAS unsigned*)(lds + (bufoff) + ldsw + _i * 8192), 16, 0, 0); } while (0)
#define PG8_LDA(dst, b, h) do { _Pragma("unroll") for (int m = 0; m < 4; ++m) _Pragma("unroll") for (int k = 0; k < 2; ++k) dst[m][k] = *(const PG8_LAS bf16x8*)(lds + PG8_SA(b, h) + aoff + m * 2048 + k * 1024); } while (0)
#define PG8_LDB(dst, b, h) do { _Pragma("unroll") for (int n = 0; n < 2; ++n) _Pragma("unroll") for (int k = 0; k < 2; ++k) dst[n][k] = *(const PG8_LAS bf16x8*)(lds + PG8_SB(b, h) + boff + n * 2048 + k * 1024); } while (0)
#define PG8_MMA(ai, bj, At, Bt) do { __builtin_amdgcn_s_setprio(1); _Pragma("unroll") for (int m = 0; m < 4; ++m) _Pragma("unroll") for (int n = 0; n < 2; ++n) _Pragma("unroll") for (int k = 0; k < 2; ++k) \
        acc[ai][bj][m][n] = __builtin_amdgcn_mfma_f32_16x16x32_bf16(Bt[n][k], At[m][k], acc[ai][bj][m][n], 0, 0, 0); __builtin_amdgcn_s_setprio(0); } while (0)
#define PG8_WAIT_V(n) asm volatile("s_waitcnt vmcnt(" #n ")" ::: "memory")
#define PG8_WAIT_L(n) asm volatile("s_waitcnt lgkmcnt(" #n ")" ::: "memory")
#define PG8_BAR __builtin_amdgcn_s_barrier()
#define PG8_SCHED __builtin_amdgcn_sched_barrier(0)
    Unit cur, nxt; int ui = 0;
    if (!S.next(0, cur)) return;
    f32x4 acc[2][2][4][2];
#pragma unroll
    for (int a = 0; a < 2; ++a)
#pragma unroll
        for (int b = 0; b < 2; ++b)
#pragma unroll
            for (int m = 0; m < 4; ++m)
#pragma unroll
                for (int n = 0; n < 2; ++n) acc[a][b][m][n] = (f32x4){0.f, 0.f, 0.f, 0.f};
    bf16x8 At[4][2], B0[2][2], B1[2][2];
    const char* cA = g.a_ptr(cur); const char* cB = g.b_ptr(cur);
    S.a_ready(cur);
    if constexpr (SP2) {
        PG8_STAGE(PG8_SB(0, 0), cB, voffB); PG8_STAGE(PG8_SB(0, 1), cB + hstep, voffB); PG8_STAGE(PG8_SA(0, 0), cA, voffA); PG8_STAGE(PG8_SA(0, 1), cA + hstep, voffA);
        if (wr == 1) PG8_BAR;
        PG8_WAIT_V(2); PG8_BAR;
        PG8_STAGE(PG8_SB(1, 0), cB + kstep, voffB); PG8_STAGE(PG8_SA(1, 0), cA + kstep, voffA); PG8_STAGE(PG8_SB(1, 1), cB + hstep + kstep, voffB);
        PG8_WAIT_V(6); PG8_BAR;
    } else {
        PG8_STAGE(PG8_SB(0, 0), cB, voffB); PG8_STAGE(PG8_SA(0, 0), cA, voffA); PG8_STAGE(PG8_SB(0, 1), cB + hstep, voffB); PG8_STAGE(PG8_SA(0, 1), cA + hstep, voffA);
        if (wr == 1) PG8_BAR;
        PG8_WAIT_V(4); PG8_BAR;
        PG8_STAGE(PG8_SB(1, 0), cB + kstep, voffB); PG8_STAGE(PG8_SA(1, 0), cA + kstep, voffA); PG8_STAGE(PG8_SB(1, 1), cB + hstep + kstep, voffB);
        PG8_WAIT_V(6); PG8_BAR;
    }
    for (;;) {
        const bool has_next = S.next(ui + 1, nxt);
        const char* nA = has_next ? g.a_ptr(nxt) : cA; const char* nB = has_next ? g.b_ptr(nxt) : cB;
        for (int t = 0; t < nt; t += 2) {
            const bool last = (t == nt - 2);
            const char* a1 = cA + (size_t)(t + 1) * kstep;
            const char* a2 = last ? nA : cA + (size_t)(t + 2) * kstep; const char* b2 = last ? nB : cB + (size_t)(t + 2) * kstep;
            const char* a3 = a2 + kstep; const char* b3 = b2 + kstep;
            if (last && has_next) S.a_ready(nxt);
            if constexpr (SP2) {
            PG8_LDB(B0, 0, 0); PG8_LDB(B1, 0, 1); PG8_SCHED; PG8_LDA(At, 0, 0); PG8_STAGE(PG8_SA(1, 1), a1 + hstep, voffA);
            PG8_WAIT_V(8); PG8_WAIT_L(0); PG8_BAR; PG8_MMA(0, 0, At, B0); PG8_MMA(0, 1, At, B1); PG8_BAR; PG8_SCHED;
            PG8_LDA(At, 0, 1); PG8_STAGE(PG8_SB(0, 0), b2, voffB); PG8_STAGE(PG8_SB(0, 1), b2 + hstep, voffB); PG8_STAGE(PG8_SA(0, 0), a2, voffA);
            PG8_WAIT_V(8); PG8_WAIT_L(0); PG8_BAR; PG8_MMA(1, 0, At, B0); PG8_MMA(1, 1, At, B1); PG8_BAR; PG8_SCHED;
            PG8_LDB(B0, 1, 0); PG8_LDB(B1, 1, 1); PG8_SCHED; PG8_LDA(At, 1, 0); PG8_STAGE(PG8_SA(0, 1), a2 + hstep, voffA);
            PG8_WAIT_V(8); PG8_WAIT_L(0); PG8_BAR; PG8_MMA(0, 0, At, B0); PG8_MMA(0, 1, At, B1); PG8_BAR; PG8_SCHED;
            PG8_LDA(At, 1, 1); PG8_STAGE(PG8_SB(1, 0), b3, voffB); PG8_STAGE(PG8_SB(1, 1), b3 + hstep, voffB); PG8_STAGE(PG8_SA(1, 0), a3, voffA);
            PG8_WAIT_V(8); PG8_WAIT_L(0); PG8_BAR; PG8_MMA(1, 0, At, B0); PG8_MMA(1, 1, At, B1); PG8_BAR; PG8_SCHED;
            } else {
            PG8_LDB(B0, 0, 0); PG8_SCHED; PG8_LDA(At, 0, 0); PG8_STAGE(PG8_SA(1, 1), a1 + hstep, voffA);
            PG8_WAIT_L(8); PG8_BAR; PG8_WAIT_L(0); PG8_MMA(0, 0, At, B0); PG8_BAR; PG8_SCHED;
            PG8_LDB(B1, 0, 1); PG8_STAGE(PG8_SB(0, 0), b2, voffB);
            PG8_BAR; PG8_WAIT_L(0); PG8_MMA(0, 1, At, B1); PG8_BAR;
            PG8_LDA(At, 0, 1); PG8_STAGE(PG8_SA(0, 0), a2, voffA);
            PG8_BAR; PG8_WAIT_L(0); PG8_MMA(1, 0, At, B0); PG8_BAR; PG8_SCHED;
            PG8_STAGE(PG8_SB(0, 1), b2 + hstep, voffB);
            PG8_WAIT_V(6); PG8_BAR; PG8_MMA(1, 1, At, B1); PG8_BAR;
            PG8_LDB(B0, 1, 0); PG8_SCHED; PG8_LDA(At, 1, 0); PG8_STAGE(PG8_SA(0, 1), a2 + hstep, voffA);
            PG8_WAIT_L(8); PG8_BAR; PG8_WAIT_L(0); PG8_MMA(0, 0, At, B0); PG8_BAR; PG8_SCHED;
            PG8_LDB(B1, 1, 1); PG8_STAGE(PG8_SB(1, 0), b3, voffB);
            PG8_BAR; PG8_WAIT_L(0); PG8_MMA(0, 1, At, B1); PG8_BAR;
            PG8_LDA(At, 1, 1); PG8_STAGE(PG8_SA(1, 0), a3, voffA);
            PG8_BAR; PG8_WAIT_L(0); PG8_MMA(1, 0, At, B0); PG8_BAR; PG8_SCHED;
            PG8_STAGE(PG8_SB(1, 1), b3 + hstep, voffB);
            PG8_WAIT_V(6); PG8_BAR; PG8_MMA(1, 1, At, B1); PG8_BAR;
            }
        }
        if constexpr (ALIGN_EPI) { if (wr == 0) PG8_BAR; }
        if constexpr (!Epi::AFTER_DRAIN) { E(acc, cur, wr, wc, fr, fq); S.done(cur); }
        if (!has_next) break;
#pragma unroll
        for (int a = 0; a < 2; ++a)
#pragma unroll
            for (int b = 0; b < 2; ++b)
#pragma unroll
                for (int m = 0; m < 4; ++m)
#pragma unroll
                    for (int n = 0; n < 2; ++n) acc[a][b][m][n] = (f32x4){0.f, 0.f, 0.f, 0.f};
        cur = nxt; cA = nA; cB = nB; ++ui;
        if constexpr (ALIGN_EPI) { if (wr == 1) PG8_BAR; }
    }
    PG8_WAIT_V(0);
    if constexpr (!ALIGN_EPI) { if (wr == 0) PG8_BAR; }
    PG8_BAR;
    if constexpr (Epi::AFTER_DRAIN) { E.fused(acc, cur, wr, wc, fr, fq, lds, wid, lane); S.done(cur); }
#undef PG8_SA
#undef PG8_SB
#undef PG8_STAGE
#undef PG8_LDA
#undef PG8_LDB
#undef PG8_MMA
#undef PG8_WAIT_V
#undef PG8_WAIT_L
#undef PG8_BAR
#undef PG8_SCHED
}
}
constexpr int BATCH = 16, SEQ = 2048, DM = 1024, NMETA = 16, NH = 16, HD = 64, DFF = 4096, CW = 31;
constexpr int MR = BATCH * SEQ;
constexpr int MROWS = MR + 256;
constexpr int NIN_SRC = 7184;
constexpr int NIN = 7168;
constexpr float RMS_EPS = 1e-6f, LN_EPS = 1e-5f;
constexpr float LOG2E = 1.4426950408889634f;
constexpr float C2 = 0.125f * LOG2E;

constexpr size_t MiB = 1u << 20;
constexpr size_t WS_SS1 = 0, WS_SS2 = 131072;
constexpr size_t WS_WIN = 1 * MiB;
constexpr size_t WS_WA = 15 * MiB, WS_WC = 17 * MiB;
constexpr size_t WS_WO2 = 19 * MiB;
constexpr size_t WS_WUP = 23 * MiB;
constexpr size_t WS_WDN = 31 * MiB;
constexpr size_t WS_LOGF = 39 * MiB;
constexpr size_t ACT_R = (size_t)MROWS * 1024 * 2;
constexpr size_t WS_XN = 42 * MiB;
constexpr size_t WS_Q = WS_XN + ACT_R, WS_K = WS_Q + ACT_R, WS_V = WS_K + ACT_R, WS_U = WS_V + ACT_R, WS_GA = WS_U + ACT_R, WS_GC = WS_GA + ACT_R;
constexpr size_t WS_END = WS_GC + ACT_R;
constexpr size_t WS_MM = WS_K;
constexpr size_t WS_H = WS_Q;
static_assert((size_t)MR * 2048 * 2 <= 2 * ACT_R && (size_t)MR * 4096 * 2 <= 4 * ACT_R, "overlays");
static_assert(WS_LOGF + (size_t)MROWS * 64 <= WS_XN, "logf fits");

constexpr int LDS_BYTES = 147456;
constexpr int NWAVES = 8;

#define LAS __attribute__((address_space(3)))
typedef unsigned short bf16;
typedef float f32x4 __attribute__((ext_vector_type(4)));
typedef float f32x2 __attribute__((ext_vector_type(2)));
typedef float f32x16 __attribute__((ext_vector_type(16)));
typedef short bf16x8 __attribute__((ext_vector_type(8)));
typedef short s16x4 __attribute__((ext_vector_type(4)));
typedef unsigned u32x4 __attribute__((ext_vector_type(4)));
typedef unsigned u32x2 __attribute__((ext_vector_type(2)));
using pg8::cvt_pk_bf16;
using pg8::sigmoid_f;

__device__ __forceinline__ float wave_sum(float v) {
#pragma unroll
    for (int o = 1; o < 64; o <<= 1) v += __shfl_xor(v, o);
    return v;
}

__device__ __forceinline__ void transpose_item(const float* W, int ldw, int k0, int srcc0, bf16* WT, int ldt, int dstr0, int dup, LAS float* scr, int lane) {
#pragma unroll 8
    for (int i = 0; i < 32; ++i) { const int kk = 2 * i + (lane >> 5); scr[kk * 33 + (lane & 31)] = W[(size_t)(k0 + kk) * ldw + srcc0 + (lane & 31)]; }
    asm volatile("s_waitcnt lgkmcnt(0)" ::: "memory");
    const int c = lane & 7;
#pragma unroll
    for (int j = 0; j < 4; ++j) { const int n = (lane >> 3) + 8 * j; const LAS float* s = scr + (8 * c) * 33 + n;
        u32x4 o; o.x = cvt_pk_bf16(s[0 * 33], s[1 * 33]); o.y = cvt_pk_bf16(s[2 * 33], s[3 * 33]); o.z = cvt_pk_bf16(s[4 * 33], s[5 * 33]); o.w = cvt_pk_bf16(s[6 * 33], s[7 * 33]);
        bf16* dst = WT + (size_t)(dstr0 + n) * ldt + k0 + 8 * c;
        *(u32x4*)dst = o; if (dup) *(u32x4*)(dst + dup) = o; }
    asm volatile("s_waitcnt lgkmcnt(0)" ::: "memory");
}
__device__ __forceinline__ int win_src_col(int n) {
    if (n < 3072) return n;
    if (n < 5120) { const int j = (n - 3072) >> 8, r = (n - 3072) & 255; return 3088 + (r < 128 ? 128 * j + r : 1024 + 128 * j + (r - 128)); }
    return n + 16;
}

struct Ptrs {
    const float *x, *meta, *g_mix, *w_in, *b_forget, *w_attn_out, *b_glu, *conv_w, *conv_b, *ln_g, *ln_b, *w_conv_out, *b_conv_out, *w_out, *g_mlp, *w_up, *w_down, *g_final;
    float* out; unsigned char* ws;
};

__device__ __forceinline__ void p0_prologue(const Ptrs& P, LAS unsigned char* lds, int bid, int G) {
    int tid = threadIdx.x; asm volatile("" : "+v"(tid)); const int lane = tid & 63, wave = __builtin_amdgcn_readfirstlane(tid >> 6);
    LAS float* scr = (LAS float*)(lds + wave * 8704);
    LAS float* wfg = (LAS float*)(lds + 69632);
    unsigned char* ws = P.ws;
    const int gw = bid * NWAVES + wave, NGW = G * NWAVES;
    for (int idx = tid; idx < 16 * 1024; idx += NWAVES * 64) { const int k = idx >> 4, h = idx & 15; wfg[h * 1024 + k] = P.w_in[(size_t)k * NIN_SRC + 3072 + h]; }
    { float* ss = (float*)(ws + WS_SS1); for (int i = bid * 512 + tid; i < 2 * MR; i += G * 512) ss[i] = 0.f; }
    constexpr int I_IN = 16 * (NIN / 32), I_SQ = 16 * 32, I_UP = 16 * 128, I_DN = 64 * 32;
    constexpr int NITEMS = I_IN + 3 * I_SQ + I_UP + I_DN;
    for (int it = gw; it < NITEMS; it += NGW) {
        int r = it;
        if (r < I_IN) { const int nb = r % (NIN / 32), kb = r / (NIN / 32); transpose_item(P.w_in, NIN_SRC, 64 * kb, win_src_col(32 * nb), (bf16*)(ws + WS_WIN), 1024, 32 * nb, 0, scr, lane); continue; } r -= I_IN;
        if (r < I_SQ) { const int nb = r % 32, kb = r / 32; transpose_item(P.w_attn_out, 1024, 64 * kb, 32 * nb, (bf16*)(ws + WS_WA), 1024, 32 * nb, 0, scr, lane); continue; } r -= I_SQ;
        if (r < I_SQ) { const int nb = r % 32, kb = r / 32; transpose_item(P.w_conv_out, 1024, 64 * kb, 32 * nb, (bf16*)(ws + WS_WC), 1024, 32 * nb, 0, scr, lane); continue; } r -= I_SQ;
        if (r < I_SQ) { const int nb = r % 32, kb = r / 32; transpose_item(P.w_out, 1024, 64 * kb, 32 * nb, (bf16*)(ws + WS_WO2), 2048, 32 * nb, 1024, scr, lane); continue; } r -= I_SQ;
        if (r < I_UP) { const int nb = r % 128, kb = r / 128; transpose_item(P.w_up, 4096, 64 * kb, 32 * nb, (bf16*)(ws + WS_WUP), 1024, 32 * nb, 0, scr, lane); continue; } r -= I_UP;
        { const int nb = r % 32, kb = r / 32; transpose_item(P.w_down, 1024, 64 * kb, 32 * nb, (bf16*)(ws + WS_WDN), 4096, 32 * nb, 0, scr, lane); }
    }
    __syncthreads();
    bf16* XN = (bf16*)(ws + WS_XN); float* logf = (float*)(ws + WS_LOGF);
    f32x4 gq[4];
#pragma unroll
    for (int j = 0; j < 4; ++j) gq[j] = *((const f32x4*)P.g_mix + lane + 64 * j);
    const int hsel = ((lane >> 5) & 1) * 8 + ((lane >> 4) & 1) * 4 + ((lane >> 3) & 1) * 2 + ((lane >> 2) & 1);
    const float bfg = P.b_forget[hsel];
    for (int m = gw; m < MROWS; m += NGW) {
        u32x2* o8 = (u32x2*)(XN + (size_t)m * 1024) + lane;
        if (m >= MR + NMETA) {
#pragma unroll
            for (int j = 0; j < 4; ++j) o8[64 * j] = (u32x2){0u, 0u};
            continue;
        }
        const float* src = (m < MR) ? P.x + (size_t)m * 1024 : P.meta + (size_t)(m - MR) * 1024;
        f32x4 v[4]; float s2 = 0.f;
#pragma unroll
        for (int j = 0; j < 4; ++j) { v[j] = *((const f32x4*)src + lane + 64 * j); s2 += (v[j].x * v[j].x + v[j].y * v[j].y) + (v[j].z * v[j].z + v[j].w * v[j].w); }
        const float rstd = 1.0f / sqrtf(wave_sum(s2) * (1.0f / 1024.0f) + RMS_EPS);
#pragma unroll
        for (int j = 0; j < 4; ++j) { v[j] = v[j] * rstd * gq[j]; u32x2 w; w.x = cvt_pk_bf16(v[j].x, v[j].y); w.y = cvt_pk_bf16(v[j].z, v[j].w); o8[64 * j] = w; }
        float p[16];
#pragma unroll
        for (int h = 0; h < 16; ++h) { float a = 0.f;
#pragma unroll
            for (int j = 0; j < 4; ++j) { const f32x4 w = *((const LAS f32x4*)(wfg + h * 1024) + lane + 64 * j); a += (v[j].x * w.x + v[j].y * w.y) + (v[j].z * w.z + v[j].w * w.w); }
            p[h] = a; }
#pragma unroll
        for (int i = 0; i < 8; ++i) { const bool up = (lane & 32) != 0; const float mine = up ? p[i + 8] : p[i], other = up ? p[i] : p[i + 8]; p[i] = mine + __shfl_xor(other, 32); }
#pragma unroll
        for (int i = 0; i < 4; ++i) { const bool up = (lane & 16) != 0; const float mine = up ? p[i + 4] : p[i], other = up ? p[i] : p[i + 4]; p[i] = mine + __shfl_xor(other, 16); }
#pragma unroll
        for (int i = 0; i < 2; ++i) { const bool up = (lane & 8) != 0; const float mine = up ? p[i + 2] : p[i], other = up ? p[i] : p[i + 2]; p[i] = mine + __shfl_xor(other, 8); }
        { const bool up = (lane & 4) != 0; const float mine = up ? p[1] : p[0], other = up ? p[0] : p[1]; p[0] = mine + __shfl_xor(other, 4); }
        float tot = p[0]; tot += __shfl_xor(tot, 2); tot += __shfl_xor(tot, 1);
        if ((lane & 3) == 0) { const float z = tot + bfg; logf[(size_t)m * 16 + hsel] = fminf(z, 0.f) - log1pf(expf(-fabsf(z))); }
    }
}

namespace att {
constexpr int KS = 144, VS = 192;
constexpr int L_K = 0, L_V = 2 * 64 * KS, L_CUM = L_V + 2 * 64 * VS, L_WS = L_CUM + 2304 * 4, L_OST = L_WS + 8 * 256, L_END = L_OST + 8 * 4096;
static_assert(L_END <= 131072, "attention LDS");
constexpr float NEG = -1.0e30f;
__device__ __forceinline__ s16x4 vtr(const LAS unsigned char* p) { typedef short v4i16_t __attribute__((ext_vector_type(4))); return __builtin_bit_cast(s16x4, __builtin_amdgcn_ds_read_tr16_b64_v4i16((LAS v4i16_t*)p)); }

__device__ __forceinline__ void attn_bh(LAS unsigned char* lds, int bh, bf16* QO, const bf16* Kg, const bf16* Vg, const float* logf) {
    int tid = threadIdx.x; asm volatile("" : "+v"(tid)); const int lane = tid & 63, wid = __builtin_amdgcn_readfirstlane(tid >> 6);
    const int b = bh >> 4, h = bh & 15, r32 = lane & 31, hi = lane >> 5;
    LAS float* cum = (LAS float*)(lds + L_CUM);
    LAS float* wsc = (LAS float*)(lds + L_WS) + wid * 64;
    LAS bf16* stg = (LAS bf16*)(lds + L_OST) + wid * 2048;
    {
        LAS float* wtot = (LAS float*)(lds + L_WS);
        float mv = (lane < 16) ? logf[(size_t)(MR + lane) * 16 + h] : 0.f;
#pragma unroll
        for (int d = 1; d < 16; d <<= 1) { const float y = __shfl_up(mv, d); if (lane >= d) mv += y; }
        const float metaTot = __shfl(mv, 15);
        if (wid == 0 && lane < 16) cum[lane] = mv * LOG2E;
        const float* lf = logf + ((size_t)b * SEQ + 4 * tid) * 16 + h;
        const float a0 = lf[0], a1 = a0 + lf[16], a2 = a1 + lf[32], a3 = a2 + lf[48];
        float xs = a3;
#pragma unroll
        for (int d = 1; d < 64; d <<= 1) { const float y = __shfl_up(xs, d); if (lane >= d) xs += y; }
        if (lane == 63) wtot[wid] = xs;
        __syncthreads();
        float off = metaTot + (xs - a3);
        for (int w = 0; w < wid; ++w) off += wtot[w];
        *(LAS f32x4*)(cum + 16 + 4 * tid) = (f32x4){(off + a0) * LOG2E, (off + a1) * LOG2E, (off + a2) * LOG2E, (off + a3) * LOG2E};
        __syncthreads();
    }
    const size_t rowb = (size_t)b * SEQ;
    const int ldrow = tid >> 3, ldch = tid & 7;
    const int vlane = ((lane >> 4) & 1) * 32 + (lane & 3) * 8 + (4 * hi + ((lane & 15) >> 2)) * VS;
    for (int qb = 0; qb < SEQ / 256; ++qb) {
        const int q0 = qb * 256 + wid * 32, qpos = q0 + r32;
        bf16* Qw = QO + (rowb + qpos) * 1024 + h * 64;
        bf16x8 qr[4];
#pragma unroll
        for (int d0 = 0; d0 < 4; ++d0) qr[d0] = *(const bf16x8*)(Qw + d0 * 16 + hi * 8);
        const float cq = cum[16 + qpos];
        float mrun = NEG, lrun = 0.f; f32x16 o0, o1;
#pragma unroll
        for (int r = 0; r < 16; ++r) { o0[r] = 0.f; o1[r] = 0.f; }
        const int NT = 4 * qb + 5, ti_max = 4 * qb + (wid >> 1) + 1;
        u32x4 kreg, vreg;
        if (ldrow < NMETA) { kreg = *(const u32x4*)(Kg + (size_t)(MR + ldrow) * 1024 + h * 64 + ldch * 8); vreg = *(const u32x4*)(Vg + (size_t)(MR + ldrow) * 1024 + h * 64 + ldch * 8); }
        else { kreg = (u32x4){0u, 0u, 0u, 0u}; vreg = kreg; }
        *(LAS u32x4*)(lds + L_K + ldrow * KS + ldch * 16) = kreg; *(LAS u32x4*)(lds + L_V + ldrow * VS + ldch * 16) = vreg;
        __syncthreads();
        for (int ti = 0; ti < NT; ++ti) {
            if (ti + 1 < NT) { const size_t gr = (rowb + 64 * ti + ldrow) * 1024 + h * 64 + ldch * 8; kreg = *(const u32x4*)(Kg + gr); vreg = *(const u32x4*)(Vg + gr); }
            if (ti <= ti_max) {
                const LAS unsigned char* Kb = lds + L_K + (ti & 1) * 64 * KS; const LAS unsigned char* Vb = lds + L_V + (ti & 1) * 64 * VS;
                f32x16 p0, p1;
#pragma unroll
                for (int r = 0; r < 16; ++r) { p0[r] = 0.f; p1[r] = 0.f; }
#pragma unroll
                for (int d0 = 0; d0 < 4; ++d0) {
                    const bf16x8 ka = *(const LAS bf16x8*)(Kb + r32 * KS + d0 * 32 + hi * 16);
                    const bf16x8 kb2 = *(const LAS bf16x8*)(Kb + (32 + r32) * KS + d0 * 32 + hi * 16);
                    p0 = __builtin_amdgcn_mfma_f32_32x32x16_bf16(ka, qr[d0], p0, 0, 0, 0);
                    p1 = __builtin_amdgcn_mfma_f32_32x32x16_bf16(kb2, qr[d0], p1, 0, 0, 0);
                }
                const int tb = (ti == 0) ? 0 : 16 + 64 * (ti - 1);
#pragma unroll
                for (int g = 0; g < 4; ++g) { const f32x4 c0 = *(const LAS f32x4*)(cum + tb + 8 * g + 4 * hi), c1 = *(const LAS f32x4*)(cum + tb + 32 + 8 * g + 4 * hi);
#pragma unroll
                    for (int e = 0; e < 4; ++e) { p0[4 * g + e] += cq - c0[e]; p1[4 * g + e] += cq - c1[e]; } }
                if (ti == 0) {
#pragma unroll
                    for (int r = 0; r < 16; ++r) { if (r >= 8) p0[r] = NEG; p1[r] = NEG; }
                } else if (ti == ti_max) {
                    const int kb0 = 64 * (ti - 1) + 4 * hi;
#pragma unroll
                    for (int r = 0; r < 16; ++r) { const int kv = kb0 + (r & 3) + 8 * (r >> 2); if (kv > qpos) p0[r] = NEG; if (kv + 32 > qpos) p1[r] = NEG; }
                }
                float mx = fmaxf(p0[0], p1[0]);
#pragma unroll
                for (int r = 1; r < 16; ++r) mx = fmaxf(mx, fmaxf(p0[r], p1[r]));
                mx = fmaxf(mx, __shfl_xor(mx, 32));
                const float mn = fmaxf(mrun, mx), alpha = __builtin_amdgcn_exp2f(mrun - mn); mrun = mn;
                float rs = 0.f;
#pragma unroll
                for (int r = 0; r < 16; ++r) { p0[r] = __builtin_amdgcn_exp2f(p0[r] - mn); p1[r] = __builtin_amdgcn_exp2f(p1[r] - mn); rs += p0[r] + p1[r]; }
                lrun = lrun * alpha + rs;
                if (__any(alpha != 1.0f)) {
                    if (hi == 0) wsc[r32] = alpha;
#pragma unroll
                    for (int g = 0; g < 4; ++g) { const f32x4 a = *(const LAS f32x4*)(wsc + 8 * g + 4 * hi);
#pragma unroll
                        for (int e = 0; e < 4; ++e) { o0[4 * g + e] *= a[e]; o1[4 * g + e] *= a[e]; } }
                }
                bf16x8 pw[4];
                { u32x4 w;
                  w.x = cvt_pk_bf16(p0[0], p0[1]); w.y = cvt_pk_bf16(p0[2], p0[3]); w.z = cvt_pk_bf16(p0[4], p0[5]); w.w = cvt_pk_bf16(p0[6], p0[7]); pw[0] = __builtin_bit_cast(bf16x8, w);
                  w.x = cvt_pk_bf16(p0[8], p0[9]); w.y = cvt_pk_bf16(p0[10], p0[11]); w.z = cvt_pk_bf16(p0[12], p0[13]); w.w = cvt_pk_bf16(p0[14], p0[15]); pw[1] = __builtin_bit_cast(bf16x8, w);
                  w.x = cvt_pk_bf16(p1[0], p1[1]); w.y = cvt_pk_bf16(p1[2], p1[3]); w.z = cvt_pk_bf16(p1[4], p1[5]); w.w = cvt_pk_bf16(p1[6], p1[7]); pw[2] = __builtin_bit_cast(bf16x8, w);
                  w.x = cvt_pk_bf16(p1[8], p1[9]); w.y = cvt_pk_bf16(p1[10], p1[11]); w.z = cvt_pk_bf16(p1[12], p1[13]); w.w = cvt_pk_bf16(p1[14], p1[15]); pw[3] = __builtin_bit_cast(bf16x8, w); }
#pragma unroll
                for (int j = 0; j < 4; ++j) {
                    const LAS unsigned char* vp = Vb + vlane + 16 * j * VS;
                    const s16x4 a0 = vtr(vp), a1 = vtr(vp + 8 * VS), b0 = vtr(vp + 64), b1 = vtr(vp + 8 * VS + 64);
                    const bf16x8 vf0 = (bf16x8){a0[0], a0[1], a0[2], a0[3], a1[0], a1[1], a1[2], a1[3]};
                    const bf16x8 vf1 = (bf16x8){b0[0], b0[1], b0[2], b0[3], b1[0], b1[1], b1[2], b1[3]};
                    o0 = __builtin_amdgcn_mfma_f32_32x32x16_bf16(pw[j], vf0, o0, 0, 0, 0);
                    o1 = __builtin_amdgcn_mfma_f32_32x32x16_bf16(pw[j], vf1, o1, 0, 0, 0);
                }
            }
            if (ti + 1 < NT) { const int nb = (ti + 1) & 1; *(LAS u32x4*)(lds + L_K + nb * 64 * KS + ldrow * KS + ldch * 16) = kreg; *(LAS u32x4*)(lds + L_V + nb * 64 * VS + ldrow * VS + ldch * 16) = vreg; }
            __syncthreads();
        }
        lrun += __shfl_xor(lrun, 32);
        if (hi == 0) wsc[32 + r32] = 1.0f / lrun;
#pragma unroll
        for (int g = 0; g < 4; ++g) { const f32x4 il = *(const LAS f32x4*)(wsc + 32 + 8 * g + 4 * hi);
#pragma unroll
            for (int e = 0; e < 4; ++e) { const int r = 4 * g + e, orow = 8 * g + 4 * hi + e;
                stg[orow * 64 + r32] = (bf16)(cvt_pk_bf16(o0[r] * il[e], 0.f) & 0xffffu);
                stg[orow * 64 + 32 + r32] = (bf16)(cvt_pk_bf16(o1[r] * il[e], 0.f) & 0xffffu); } }
#pragma unroll
        for (int i = 0; i < 4; ++i) { const int row = i * 8 + (lane >> 3), ch = lane & 7; const u32x4 v = *(const LAS u32x4*)(stg + row * 64 + ch * 8);
            *(u32x4*)(QO + (rowb + q0 + row) * 1024 + h * 64 + ch * 8) = v; }
    }
    __syncthreads();
}
}

__device__ __forceinline__ void conv_tile(LAS unsigned char* lds, int tile, const bf16* U, const float* cw, const float* cb, const float* lng, const float* lnb, bf16* OUT) {
    int tid = threadIdx.x; asm volatile("" : "+v"(tid)); const int lane = tid & 63, wid = __builtin_amdgcn_readfirstlane(tid >> 6);
    const int b = tile >> 4, s0 = (tile & 15) * 128, ch = 2 * tid;
    LAS float* ct = (LAS float*)lds;
    f32x2 w[CW];
#pragma unroll
    for (int j = 0; j < CW; ++j) w[j] = *(const f32x2*)(cw + j * 1024 + ch);
    const f32x2 bias = *(const f32x2*)(cb + ch);
    f32x2 win[46];
    const unsigned* U32 = (const unsigned*)U;
#pragma unroll
    for (int i = 0; i < 30; ++i) {
        unsigned v = 0u;
        if (s0 == 0) { if (i >= 14) v = U32[(size_t)(MR + i - 14) * 512 + tid]; }
        else v = U32[((size_t)b * SEQ + s0 - 30 + i) * 512 + tid];
        win[i] = (f32x2){pg8::bf_lo(v), pg8::bf_hi(v)};
    }
#pragma unroll 1
    for (int chunk = 0; chunk < 8; ++chunk) {
        const size_t rbase = (size_t)b * SEQ + s0 + chunk * 16;
#pragma unroll
        for (int i = 0; i < 16; ++i) { const unsigned v = U32[(rbase + i) * 512 + tid]; win[30 + i] = (f32x2){pg8::bf_lo(v), pg8::bf_hi(v)}; }
#pragma unroll
        for (int i = 0; i < 16; ++i) {
            f32x2 a = bias;
#pragma unroll
            for (int j = 0; j < CW; ++j) a = __builtin_elementwise_fma(w[j], win[i + j], a);
            *(LAS f32x2*)(ct + i * 1024 + ch) = a;
        }
#pragma unroll
        for (int i = 0; i < 30; ++i) win[i] = win[i + 16];
        __syncthreads();
#pragma unroll 1
        for (int rr = 0; rr < 2; ++rr) {
            const int row = 2 * wid + rr;
            f32x4 x[4]; float s = 0.f;
#pragma unroll
            for (int j = 0; j < 4; ++j) { x[j] = *((const LAS f32x4*)(ct + row * 1024) + lane + 64 * j); s += (x[j].x + x[j].y) + (x[j].z + x[j].w); }
            const float mean = wave_sum(s) * (1.0f / 1024.0f); float q = 0.f;
#pragma unroll
            for (int j = 0; j < 4; ++j) { x[j] = x[j] - mean; q += (x[j].x * x[j].x + x[j].y * x[j].y) + (x[j].z * x[j].z + x[j].w * x[j].w); }
            const float rstd = 1.0f / sqrtf(wave_sum(q) * (1.0f / 1024.0f) + LN_EPS);
            u32x2* o8 = (u32x2*)(OUT + (rbase + row) * 1024) + lane;
#pragma unroll
            for (int j = 0; j < 4; ++j) { const f32x4 g = *((const f32x4*)lng + lane + 64 * j), bb = *((const f32x4*)lnb + lane + 64 * j);
                f32x4 y = x[j] * rstd * g + bb;
#pragma unroll
                for (int e = 0; e < 4; ++e) y[e] = y[e] * sigmoid_f(y[e]);
                u32x2 wv; wv.x = cvt_pk_bf16(y.x, y.y); wv.y = cvt_pk_bf16(y.z, y.w); o8[64 * j] = wv; }
        }
        __syncthreads();
    }
}

__global__ void __launch_bounds__(NWAVES * 64, 2) fox_fwd(Ptrs P) {
    extern __shared__ __attribute__((aligned(16))) unsigned char lds_raw[];
    LAS unsigned char* lds = (LAS unsigned char*)lds_raw;
    cg::grid_group grid = cg::this_grid();
    const int bid = blockIdx.x, G = gridDim.x;
    unsigned char* ws = P.ws;
    bf16* XN = (bf16*)(ws + WS_XN); bf16* Qb = (bf16*)(ws + WS_Q); bf16* Kb = (bf16*)(ws + WS_K); bf16* Vb = (bf16*)(ws + WS_V); bf16* Ub = (bf16*)(ws + WS_U);
    bf16* GA = (bf16*)(ws + WS_GA); bf16* GC = (bf16*)(ws + WS_GC); bf16* MM = (bf16*)(ws + WS_MM); bf16* Hb = (bf16*)(ws + WS_H);
    float* ss1 = (float*)(ws + WS_SS1); float* ss2 = (float*)(ws + WS_SS2); float* logf = (float*)(ws + WS_LOGF);

    p0_prologue(P, lds, bid, G);
    grid.sync();
    {
        pg8::GemmPlain g{XN, (const bf16*)(ws + WS_WIN), 1024}; pg8::InProjOrder S; S.init(MR, NIN, G, bid);
        pg8::EpiInProj E{Qb, Kb, Vb, Ub, GA, GC, P.b_glu, C2};
        pg8::gemm_phase<pg8::EpiInProj, pg8::InProjOrder, pg8::GemmPlain, true, true>(lds, g, S, E);
    }
    grid.sync();
    for (int bh = bid; bh < BATCH * NH; bh += G) att::attn_bh(lds, bh, Qb, Kb, Vb, logf);
    for (int t = bid; t < MR / 128; t += G) conv_tile(lds, t, Ub, P.conv_w, P.conv_b, P.ln_g, P.ln_b, XN);
    grid.sync();
    {
        pg8::GemmBranch g{Qb, XN, (const bf16*)(ws + WS_WA), (const bf16*)(ws + WS_WC), 1024}; pg8::StaticOrder S; S.init(MR, 2048, G, bid);
        pg8::EpiBranch E{MM, GA, GC, P.b_conv_out};
        pg8::gemm_phase<pg8::EpiBranch, pg8::StaticOrder, pg8::GemmBranch, true, true>(lds, g, S, E);
    }
    grid.sync();
    {
        pg8::GemmPlain g{MM, (const bf16*)(ws + WS_WO2), 2048}; pg8::StaticOrder S; S.init(MR, 1024, G, bid);
        pg8::EpiResid<true> E{P.x, P.out, ss1, XN, P.g_mlp};
        pg8::gemm_phase<pg8::EpiResid<true>, pg8::StaticOrder, pg8::GemmPlain, true, true>(lds, g, S, E);
    }
    grid.sync();
    {
        pg8::GemmPlain g{XN, (const bf16*)(ws + WS_WUP), 1024}; pg8::StaticOrder S; S.init(MR, DFF, G, bid);
        pg8::EpiUp E{Hb, ss1, RMS_EPS};
        pg8::gemm_phase<pg8::EpiUp, pg8::StaticOrder, pg8::GemmPlain, true, true>(lds, g, S, E);
    }
    grid.sync();
    {
        pg8::GemmPlain g{Hb, (const bf16*)(ws + WS_WDN), DFF}; pg8::StaticOrder S; S.init(MR, 1024, G, bid);
        pg8::EpiResid<false> E{P.out, P.out, ss2, nullptr, nullptr};
        pg8::gemm_phase<pg8::EpiResid<false>, pg8::StaticOrder, pg8::GemmPlain, true, true>(lds, g, S, E);
    }
    grid.sync();
    {
        int tid = threadIdx.x; asm volatile("" : "+v"(tid)); const int lane = tid & 63, wave = __builtin_amdgcn_readfirstlane(tid >> 6);
        const int gw = bid * NWAVES + wave, NGW = G * NWAVES;
        f32x4 gf[4];
#pragma unroll
        for (int j = 0; j < 4; ++j) gf[j] = *((const f32x4*)P.g_final + lane + 64 * j);
        for (int m = gw; m < MR; m += NGW) {
            f32x4* row = (f32x4*)(P.out + (size_t)m * 1024) + lane; const float rstd = 1.0f / sqrtf(ss2[m] * (1.0f / 1024.0f) + RMS_EPS);
#pragma unroll
            for (int j = 0; j < 4; ++j) row[64 * j] = row[64 * j] * rstd * gf[j];
        }
    }
}

extern "C" void kernel_launch(void* const* d_in, const int* in_sizes, int n_in, void* d_out, int out_size, void* d_ws, size_t ws_size, hipStream_t stream) {
    static int grid = 0;
    if (grid == 0) {
        if (n_in != 18 || in_sizes[0] != MR * DM || out_size != MR * DM || ws_size < WS_END) { fprintf(stderr, "kernel_launch: unexpected shapes (n_in %d, in0 %d, out %d, ws %zu need %zu)\n", n_in, n_in > 0 ? in_sizes[0] : -1, out_size, ws_size, (size_t)WS_END); grid = -1; return; }
        int dev = 0, cus = 0, per_cu = 0;
        if (hipGetDevice(&dev) != hipSuccess || hipDeviceGetAttribute(&cus, hipDeviceAttributeMultiprocessorCount, dev) != hipSuccess) { grid = -1; return; }
        if (hipFuncSetAttribute((const void*)fox_fwd, hipFuncAttributeMaxDynamicSharedMemorySize, LDS_BYTES) != hipSuccess) { fprintf(stderr, "kernel_launch: hipFuncSetAttribute failed\n"); grid = -1; return; }
        if (hipOccupancyMaxActiveBlocksPerMultiprocessor(&per_cu, (const void*)fox_fwd, NWAVES * 64, LDS_BYTES) != hipSuccess || per_cu < 1) { fprintf(stderr, "kernel_launch: occupancy query failed (%d)\n", per_cu); (void)hipGetLastError(); per_cu = 1; }
        grid = cus * (per_cu > 1 ? 1 : per_cu);
        if (grid > 256) grid = 256;
    }
    if (grid < 0) return;
    Ptrs p{};
    const float** f = (const float**)&p;
    for (int i = 0; i < 18; ++i) f[i] = (const float*)d_in[i];
    p.out = (float*)d_out; p.ws = (unsigned char*)d_ws;
    void* args[] = {&p};
    hipError_t e = hipLaunchCooperativeKernel((const void*)fox_fwd, dim3(grid), dim3(NWAVES * 64), args, LDS_BYTES, stream);
    if (e != hipSuccess) fprintf(stderr, "kernel_launch: cooperative launch failed: %s (grid %d)\n", hipGetErrorString(e), grid);
}
```

```cpp
#include <hip/hip_runtime.h>
#include <hip/hip_cooperative_groups.h>
#include <cstdio>
#include <cstdint>
namespace cg = cooperative_groups;
namespace pg8 {
#define PG8_LAS __attribute__((address_space(3)))
typedef unsigned short bf16_t;
typedef short bf16x8 __attribute__((ext_vector_type(8)));
typedef float f32x4 __attribute__((ext_vector_type(4)));
typedef unsigned u32x4 __attribute__((ext_vector_type(4)));
constexpr int BM = 256, BK = 64, HALF = 128, HTB = HALF * BK * 2  , STAGE_BYTES = 8 * HTB, NXCD = 8, WGM = 8;

__host__ __device__ __forceinline__ int lds_byte(int r, int c) { const int st = (r >> 4) * 2 + (c >> 5), rr = r & 15, cc = c & 31, ob = rr * 64 + cc * 2; return st * 1024 + (ob ^ (((ob >> 9) & 1) << 5)); }
__host__ __device__ __forceinline__ void stage_rc(int b, int& R, int& C) { const int st = b / 1024, sb = b % 1024, swz = sb ^ (((sb >> 9) & 1) << 5); R = (st >> 1) * 16 + swz / 64; C = (st & 1) * 32 + (swz % 64) / 2; }
__host__ __device__ __forceinline__ int perm32(int rho) { const int n = rho >> 4, i = rho & 15; return 8 * (i >> 2) + 4 * n + (i & 3); }

struct Unit { int pm, pn; };
struct Gemm { const bf16_t* A; const bf16_t* Bt; int M, N, K; };

struct StaticOrder {
    int nM, nN, nwg, G, c;
    __host__ __device__ void init(int M, int N, int G_, int c_) { nM = M / BM; nN = N / BM; nwg = nM * nN; G = G_; c = c_; }
    __host__ __device__ bool next(int i, Unit& u) const {
        const long L = (long)i * G + c; if (L >= nwg) return false;
        int wgid = (int)L; { const int q = nwg / NXCD, r = nwg % NXCD, xcd = wgid % NXCD, off = wgid / NXCD; wgid = (xcd < r ? xcd * (q + 1) : r * (q + 1) + (xcd - r) * q) + off; }
        const int nig = WGM * nN, gid = wgid / nig, fm = gid * WGM, gsz = (nM - fm) < WGM ? (nM - fm) : WGM;
        u.pm = fm + ((wgid % nig) % gsz); u.pn = (wgid % nig) / gsz; return true;
    }
    __device__ __forceinline__ void a_ready(const Unit&) const {}
    __device__ __forceinline__ void done(const Unit&) const {}
};

__device__ __forceinline__ unsigned cvt_pk_bf16(float lo, float hi) { unsigned r; asm volatile("v_cvt_pk_bf16_f32 %0, %1, %2" : "=v"(r) : "v"(lo), "v"(hi)); return r; }
typedef unsigned u32x2 __attribute__((ext_vector_type(2)));
__device__ __forceinline__ float sigmoid_f(float x) { return __builtin_amdgcn_rcpf(1.0f + __builtin_amdgcn_exp2f(-1.4426950408889634f * x)); }

struct GemmPlain { const bf16_t* A; const bf16_t* Bt; int K;
    __device__ __forceinline__ const char* a_ptr(const Unit& u) const { return (const char*)A + (size_t)u.pm * (size_t)(BM * 2) * K; }
    __device__ __forceinline__ const char* b_ptr(const Unit& u) const { return (const char*)Bt + (size_t)u.pn * (size_t)(BM * 2) * K; } };
struct GemmBranch { const bf16_t* A0; const bf16_t* A1; const bf16_t* B0; const bf16_t* B1; int K;
    __device__ __forceinline__ const char* a_ptr(const Unit& u) const { return (const char*)(u.pn < 4 ? A0 : A1) + (size_t)u.pm * (size_t)(BM * 2) * K; }
    __device__ __forceinline__ const char* b_ptr(const Unit& u) const { return (const char*)(u.pn < 4 ? B0 : B1) + (size_t)(u.pn & 3) * (size_t)(BM * 2) * K; } };

struct InProjOrder {
    StaticOrder so;
    __device__ void init(int M, int N, int G_, int c_) { so.init(M, N, G_, c_); }
    __device__ bool next(int i, Unit& u) const {
        const long L = (long)i * so.G + so.c;
        if (L < so.nwg) return so.next(i, u);
        const int e = (int)(L - so.nwg); if (e >= 16) return false;
        u.pm = so.nM; u.pn = 4 + e; return true;
    }
    __device__ __forceinline__ void a_ready(const Unit&) const {}
    __device__ __forceinline__ void done(const Unit&) const {}
};

struct EpiInProj {
    static constexpr bool PERM = true, AFTER_DRAIN = false;
    bf16_t *Q, *Kb, *Vb, *Ub, *GA, *GC; const float* bglu; float c2;
    __device__ __forceinline__ void operator()(const f32x4 (&acc)[2][2][4][2], const Unit& u, int wr, int wc, int fr, int fq) const {
        const int row0 = u.pm * BM + wr * 64 + fr; const int pn = u.pn;
        if (pn >= 12 && pn < 20) {
            const int ch0 = (pn - 12) * 128 + wc * 32 + 8 * fq;
            f32x4 ba[2], bb[2];
#pragma unroll
            for (int n = 0; n < 2; ++n) { ba[n] = *(const f32x4*)(bglu + ch0 + 4 * n); bb[n] = *(const f32x4*)(bglu + 1024 + ch0 + 4 * n); }
#pragma unroll
            for (int ai = 0; ai < 2; ++ai)
#pragma unroll
                for (int m = 0; m < 4; ++m) {
                    bf16_t* rowp = Ub + (size_t)(row0 + ai * HALF + m * 16) * 1024 + ch0;
                    float o[8];
#pragma unroll
                    for (int n = 0; n < 2; ++n)
#pragma unroll
                        for (int e = 0; e < 4; ++e) { const float a = acc[ai][0][m][n][e] + ba[n][e], b = acc[ai][1][m][n][e] + bb[n][e]; o[4 * n + e] = a * sigmoid_f(b); }
                    u32x4 w; w.x = cvt_pk_bf16(o[0], o[1]); w.y = cvt_pk_bf16(o[2], o[3]); w.z = cvt_pk_bf16(o[4], o[5]); w.w = cvt_pk_bf16(o[6], o[7]);
                    *(u32x4*)rowp = w;
                }
            return;
        }
        bf16_t* base; int colt; float sc = 1.f; bool sg = false;
        if (pn < 4) { base = Q; colt = pn * BM; sc = c2; }
        else if (pn < 8) { base = Kb; colt = (pn - 4) * BM; }
        else if (pn < 12) { base = Vb; colt = (pn - 8) * BM; }
        else if (pn < 24) { base = GA; colt = (pn - 20) * BM; sg = true; }
        else { base = GC; colt = (pn - 24) * BM; sg = true; }
        const int col0 = colt + wc * 32 + 8 * fq;
#pragma unroll
        for (int ai = 0; ai < 2; ++ai)
#pragma unroll
            for (int m = 0; m < 4; ++m) { bf16_t* rowp = base + (size_t)(row0 + ai * HALF + m * 16) * 1024 + col0;
#pragma unroll
                for (int bj = 0; bj < 2; ++bj) { f32x4 v0 = acc[ai][bj][m][0], v1 = acc[ai][bj][m][1];
                    if (sg) {
#pragma unroll
                        for (int e = 0; e < 4; ++e) { v0[e] = sigmoid_f(v0[e]); v1[e] = sigmoid_f(v1[e]); } }
                    else { v0 = v0 * sc; v1 = v1 * sc; }
                    u32x4 w; w.x = cvt_pk_bf16(v0[0], v0[1]); w.y = cvt_pk_bf16(v0[2], v0[3]); w.z = cvt_pk_bf16(v1[0], v1[1]); w.w = cvt_pk_bf16(v1[2], v1[3]);
                    *(u32x4*)(rowp + bj * HALF) = w; } }
    }
};

__device__ __forceinline__ float bf_lo(unsigned w) { return __uint_as_float(w << 16); }
__device__ __forceinline__ float bf_hi(unsigned w) { return __uint_as_float(w & 0xffff0000u); }

struct EpiBranch {
    static constexpr bool PERM = true, AFTER_DRAIN = false;
    bf16_t* MM; const bf16_t *GA, *GC; const float* bc;
    __device__ __forceinline__ void operator()(const f32x4 (&acc)[2][2][4][2], const Unit& u, int wr, int wc, int fr, int fq) const {
        const int row0 = u.pm * BM + wr * 64 + fr; const bool cv = u.pn >= 4;
        const bf16_t* G = cv ? GC : GA; const int gcol0 = (u.pn & 3) * BM + wc * 32 + 8 * fq; const int ocol0 = u.pn * BM + wc * 32 + 8 * fq;
        f32x4 bv[2][2];
#pragma unroll
        for (int bj = 0; bj < 2; ++bj)
#pragma unroll
            for (int n = 0; n < 2; ++n) bv[bj][n] = cv ? *(const f32x4*)(bc + gcol0 + bj * HALF + 4 * n) : (f32x4){0.f, 0.f, 0.f, 0.f};
#pragma unroll
        for (int ai = 0; ai < 2; ++ai)
#pragma unroll
            for (int m = 0; m < 4; ++m) { const size_t r = (size_t)(row0 + ai * HALF + m * 16);
#pragma unroll
                for (int bj = 0; bj < 2; ++bj) {
                    const u32x4 g = *(const u32x4*)(G + r * 1024 + gcol0 + bj * HALF);
                    const f32x4 v0 = acc[ai][bj][m][0] + bv[bj][0], v1 = acc[ai][bj][m][1] + bv[bj][1];
                    u32x4 w;
                    w.x = cvt_pk_bf16(v0[0] * bf_lo(g.x), v0[1] * bf_hi(g.x)); w.y = cvt_pk_bf16(v0[2] * bf_lo(g.y), v0[3] * bf_hi(g.y));
                    w.z = cvt_pk_bf16(v1[0] * bf_lo(g.z), v1[1] * bf_hi(g.z)); w.w = cvt_pk_bf16(v1[2] * bf_lo(g.w), v1[3] * bf_hi(g.w));
                    *(u32x4*)(MM + r * 2048 + ocol0 + bj * HALF) = w; } }
    }
};

template <bool WRITE_XN> struct EpiResid {
    static constexpr bool PERM = false, AFTER_DRAIN = false;
    const float* base; float* out; float* ss; bf16_t* XN; const float* gain;
    __device__ __forceinline__ void operator()(const f32x4 (&acc)[2][2][4][2], const Unit& u, int wr, int wc, int fr, int fq) const {
        const int col0 = u.pn * BM + wc * 32 + 4 * fq;
        f32x4 gv[2][2];
        if (WRITE_XN) {
#pragma unroll
            for (int bj = 0; bj < 2; ++bj)
#pragma unroll
                for (int n = 0; n < 2; ++n) gv[bj][n] = *(const f32x4*)(gain + col0 + bj * HALF + n * 16);
        }
#pragma unroll
        for (int ai = 0; ai < 2; ++ai)
#pragma unroll
            for (int m = 0; m < 4; ++m) { const int r = u.pm * BM + ai * HALF + wr * 64 + m * 16 + fr; const size_t off = (size_t)r * 1024 + col0; float sq = 0.f;
#pragma unroll
                for (int bj = 0; bj < 2; ++bj)
#pragma unroll
                    for (int n = 0; n < 2; ++n) { const size_t o = off + bj * HALF + n * 16; const f32x4 h = *(const f32x4*)(base + o) + acc[ai][bj][m][n];
                        *(f32x4*)(out + o) = h; sq += (h[0] * h[0] + h[1] * h[1]) + (h[2] * h[2] + h[3] * h[3]);
                        if (WRITE_XN) { const f32x4 y = h * gv[bj][n]; u32x2 w; w.x = cvt_pk_bf16(y[0], y[1]); w.y = cvt_pk_bf16(y[2], y[3]); *(u32x2*)(XN + o) = w; } }
                sq += __shfl_xor(sq, 16); sq += __shfl_xor(sq, 32);
                if (fq == 0) atomicAdd(ss + r, sq); }
    }
};

struct EpiUp {
    static constexpr bool PERM = true, AFTER_DRAIN = false;
    bf16_t* H; const float* ss; float eps;
    __device__ __forceinline__ void operator()(const f32x4 (&acc)[2][2][4][2], const Unit& u, int wr, int wc, int fr, int fq) const {
        const int row0 = u.pm * BM + wr * 64 + fr; const int col0 = u.pn * BM + wc * 32 + 8 * fq;
#pragma unroll
        for (int ai = 0; ai < 2; ++ai)
#pragma unroll
            for (int m = 0; m < 4; ++m) { const int r = row0 + ai * HALF + m * 16; const float r2 = 1.0f / (ss[r] * (1.0f / 1024.0f) + eps);
                bf16_t* rowp = H + (size_t)r * 4096 + col0;
#pragma unroll
                for (int bj = 0; bj < 2; ++bj) { f32x4 v0 = acc[ai][bj][m][0], v1 = acc[ai][bj][m][1];
#pragma unroll
                    for (int e = 0; e < 4; ++e) { const float a = fmaxf(v0[e], 0.f), b = fmaxf(v1[e], 0.f); v0[e] = a * a * r2; v1[e] = b * b * r2; }
                    u32x4 w; w.x = cvt_pk_bf16(v0[0], v0[1]); w.y = cvt_pk_bf16(v0[2], v0[3]); w.z = cvt_pk_bf16(v1[0], v1[1]); w.w = cvt_pk_bf16(v1[2], v1[3]);
                    *(u32x4*)(rowp + bj * HALF) = w; } }
    }
};

template <class Epi, class Sched, class GG, bool ALIGN_EPI = false, bool SP2 = false>
__device__ __forceinline__ void gemm_phase(PG8_LAS unsigned char* lds, const GG g, const Sched& S, const Epi& E) {
    int tid_ = threadIdx.x; asm volatile("" : "+v"(tid_));
    const int tid = tid_, wid = __builtin_amdgcn_readfirstlane(tid >> 6), lane = tid & 63, wr = wid >> 2, wc = wid & 3, fr = lane & 15, fq = lane >> 4;
    const int K = g.K, nt = K / BK;
    unsigned voffA[2], voffB[2];
#pragma unroll
    for (int i = 0; i < 2; ++i) { int R, C; stage_rc(tid * 16 + i * 8192, R, C); const int Rb = Epi::PERM ? ((R & ~31) + perm32(R & 31)) : R;
        voffA[i] = (unsigned)(R * K + C) * 2u; voffB[i] = (unsigned)(Rb * K + C) * 2u; }
    const size_t kstep = (size_t)(BK * 2);
    const size_t hstep = (size_t)HALF * K * 2;
    const unsigned ldsw = (unsigned)wid * 1024u;
    const int aoff = lds_byte(wr * 64 + fr, fq * 8), boff = lds_byte(wc * 32 + fr, fq * 8);
#define PG8_SA(b, h) (((b) * 2 + (h)) * HTB)
#define PG8_SB(b, h) ((4 + (b) * 2 + (h)) * HTB)
#define PG8_STAGE(bufoff, gbase, voff) do { _Pragma("unroll") for (int _i = 0; _i < 2; ++_i) \
        __builtin_amdgcn_global_load_lds((const unsigned*)((const char*)(gbase) + (voff)[_i]), (PG8_LAS unsigned*)(lds + (bufoff) + ldsw + _i * 8192), 16, 0, 0); } while (0)
#define PG8_LDA(dst, b, h) do { _Pragma("unroll") for (int m = 0; m < 4; ++m) _Pragma("unroll") for (int k = 0; k < 2; ++k) dst[m][k] = *(const PG8_LAS bf16x8*)(lds + PG8_SA(b, h) + aoff + m * 2048 + k * 1024); } while (0)
#define PG8_LDB(dst, b, h) do { _Pragma("unroll") for (int n = 0; n < 2; ++n) _Pragma("unroll") for (int k = 0; k < 2; ++k) dst[n][k] = *(const PG8_LAS bf16x8*)(lds + PG8_SB(b, h) + boff + n * 2048 + k * 1024); } while (0)
#define PG8_MMA(ai, bj, At, Bt) do { __builtin_amdgcn_s_setprio(1); _Pragma("unroll") for (int m = 0; m < 4; ++m) _Pragma("unroll") for (int n = 0; n < 2; ++n) _Pragma("unroll") for (int k = 0; k < 2; ++k) \
        acc[ai][bj][m][n] = __builtin_amdgcn_mfma_f32_16x16x32_bf16(Bt[n][k], At[m][k], acc[ai][bj][m][n], 0, 0, 0); __builtin_amdgcn_s_setprio(0); } while (0)
#define PG8_WAIT_V(n) asm volatile("s_waitcnt vmcnt(" #n ")" ::: "memory")
#define PG8_WAIT_L(n) asm volatile("s_waitcnt lgkmcnt(" #n ")" ::: "memory")
#define PG8_BAR __builtin_amdgcn_s_barrier()
#define PG8_SCHED __builtin_amdgcn_sched_barrier(0)
    Unit cur, nxt; int ui = 0;
    if (!S.next(0, cur)) return;
    f32x4 acc[2][2][4][2];
#pragma unroll
    for (int a = 0; a < 2; ++a)
#pragma unroll
        for (int b = 0; b < 2; ++b)
#pragma unroll
            for (int m = 0; m < 4; ++m)
#pragma unroll
                for (int n = 0; n < 2; ++n) acc[a][b][m][n] = (f32x4){0.f, 0.f, 0.f, 0.f};
    bf16x8 At[4][2], B0[2][2], B1[2][2];
    const char* cA = g.a_ptr(cur); const char* cB = g.b_ptr(cur);
    S.a_ready(cur);
    if constexpr (SP2) {
        PG8_STAGE(PG8_SB(0, 0), cB, voffB); PG8_STAGE(PG8_SB(0, 1), cB + hstep, voffB); PG8_STAGE(PG8_SA(0, 0), cA, voffA); PG8_STAGE(PG8_SA(0, 1), cA + hstep, voffA);
        if (wr == 1) PG8_BAR;
        PG8_WAIT_V(2); PG8_BAR;
        PG8_STAGE(PG8_SB(1, 0), cB + kstep, voffB); PG8_STAGE(PG8_SA(1, 0), cA + kstep, voffA); PG8_STAGE(PG8_SB(1, 1), cB + hstep + kstep, voffB);
        PG8_WAIT_V(6); PG8_BAR;
    } else {
        PG8_STAGE(PG8_SB(0, 0), cB, voffB); PG8_STAGE(PG8_SA(0, 0), cA, voffA); PG8_STAGE(PG8_SB(0, 1), cB + hstep, voffB); PG8_STAGE(PG8_SA(0, 1), cA + hstep, voffA);
        if (wr == 1) PG8_BAR;
        PG8_WAIT_V(4); PG8_BAR;
        PG8_STAGE(PG8_SB(1, 0), cB + kstep, voffB); PG8_STAGE(PG8_SA(1, 0), cA + kstep, voffA); PG8_STAGE(PG8_SB(1, 1), cB + hstep + kstep, voffB);
        PG8_WAIT_V(6); PG8_BAR;
    }
    for (;;) {
        const bool has_next = S.next(ui + 1, nxt);
        const char* nA = has_next ? g.a_ptr(nxt) : cA; const char* nB = has_next ? g.b_ptr(nxt) : cB;
        for (int t = 0; t < nt; t += 2) {
            const bool last = (t == nt - 2);
            const char* a1 = cA + (size_t)(t + 1) * kstep;
            const char* a2 = last ? nA : cA + (size_t)(t + 2) * kstep; const char* b2 = last ? nB : cB + (size_t)(t + 2) * kstep;
            const char* a3 = a2 + kstep; const char* b3 = b2 + kstep;
            if (last && has_next) S.a_ready(nxt);
            if constexpr (SP2) {
            PG8_LDB(B0, 0, 0); PG8_LDB(B1, 0, 1); PG8_SCHED; PG8_LDA(At, 0, 0); PG8_STAGE(PG8_SA(1, 1), a1 + hstep, voffA);
            PG8_WAIT_V(8); PG8_WAIT_L(0); PG8_BAR; PG8_MMA(0, 0, At, B0); PG8_MMA(0, 1, At, B1); PG8_BAR; PG8_SCHED;
            PG8_LDA(At, 0, 1); PG8_STAGE(PG8_SB(0, 0), b2, voffB); PG8_STAGE(PG8_SB(0, 1), b2 + hstep, voffB); PG8_STAGE(PG8_SA(0, 0), a2, voffA);
            PG8_WAIT_V(8); PG8_WAIT_L(0); PG8_BAR; PG8_MMA(1, 0, At, B0); PG8_MMA(1, 1, At, B1); PG8_BAR; PG8_SCHED;
            PG8_LDB(B0, 1, 0); PG8_LDB(B1, 1, 1); PG8_SCHED; PG8_LDA(At, 1, 0); PG8_STAGE(PG8_SA(0, 1), a2 + hstep, voffA);
            PG8_WAIT_V(8); PG8_WAIT_L(0); PG8_BAR; PG8_MMA(0, 0, At, B0); PG8_MMA(0, 1, At, B1); PG8_BAR; PG8_SCHED;
            PG8_LDA(At, 1, 1); PG8_STAGE(PG8_SB(1, 0), b3, voffB); PG8_STAGE(PG8_SB(1, 1), b3 + hstep, voffB); PG8_STAGE(PG8_SA(1, 0), a3, voffA);
            PG8_WAIT_V(8); PG8_WAIT_L(0); PG8_BAR; PG8_MMA(1, 0, At, B0); PG8_MMA(1, 1, At, B1); PG8_BAR; PG8_SCHED;
            } else {
            PG8_LDB(B0, 0, 0); PG8_SCHED; PG8_LDA(At, 0, 0); PG8_STAGE(PG8_SA(1, 1), a1 + hstep, voffA);
            PG8_WAIT_L(8); PG8_BAR; PG8_WAIT_L(0); PG8_MMA(0, 0, At, B0); PG8_BAR; PG8_SCHED;
            PG8_LDB(B1, 0, 1); PG8_STAGE(PG8_SB(0, 0), b2, voffB);
            PG8_BAR; PG8_WAIT_L(0); PG8_MMA(0, 1, At, B1); PG8_BAR;
            PG8_LDA(At, 0, 1); PG8_STAGE(PG8_SA(0, 0), a2, voffA);
            PG8_BAR; PG8_WAIT_L(0); PG8_MMA(1, 0, At, B0); PG8_BAR; PG8_SCHED;
            PG8_STAGE(PG8_SB(0, 1), b2 + hstep, voffB);
            PG8_WAIT_V(6); PG8_BAR; PG8_MMA(1, 1, At, B1); PG8_BAR;
            PG8_LDB(B0, 1, 0); PG8_SCHED; PG8_LDA(At, 1, 0); PG8_STAGE(PG8_SA(0, 1), a2 + hstep, voffA);
            PG8_WAIT_L(8); PG8_BAR; PG8_WAIT_L(0); PG8_MMA(0, 0, At, B0); PG8_BAR; PG8_SCHED;
            PG8_LDB(B1, 1, 1); PG8_STAGE(PG8_SB(1, 0), b3, voffB);
            PG8_BAR; PG8_WAIT_L(0); PG8_MMA(0, 1, At, B1); PG8_BAR;
            PG8_LDA(At, 1, 1); PG8_STAGE(PG8_SA(1, 0), a3, voffA);
            PG8_BAR; PG8_WAIT_L(0); PG8_MMA(1, 0, At, B0); PG8_BAR; PG8_SCHED;
            PG8_STAGE(PG8_SB(1, 1), b3 + hstep, voffB);
            PG8_WAIT_V(6); PG8_BAR; PG8_MMA(1, 1, At, B1); PG8_BAR;
            }
        }
        if constexpr (ALIGN_EPI) { if (wr == 0) PG8_BAR; }
        if constexpr (!Epi::AFTER_DRAIN) { E(acc, cur, wr, wc, fr, fq); S.done(cur); }
        if (!has_next) break;
#pragma unroll
        for (int a = 0; a < 2; ++a)
#pragma unroll
            for (int b = 0; b < 2; ++b)
#pragma unroll
                for (int m = 0; m < 4; ++m)
#pragma unroll
                    for (int n = 0; n < 2; ++n) acc[a][b][m][n] = (f32x4){0.f, 0.f, 0.f, 0.f};
        cur = nxt; cA = nA; cB = nB; ++ui;
        if constexpr (ALIGN_EPI) { if (wr == 1) PG8_BAR; }
    }
    PG8_WAIT_V(0);
    if constexpr (!ALIGN_EPI) { if (wr == 0) PG8_BAR; }
    PG8_BAR;
    if constexpr (Epi::AFTER_DRAIN) { E.fused(acc, cur, wr, wc, fr, fq, lds, wid, lane); S.done(cur); }
#undef PG8_SA
#undef PG8_SB
#undef PG8_STAGE
#undef PG8_LDA
#undef PG8_LDB
#undef PG8_MMA
#undef PG8_WAIT_V
#undef PG8_WAIT_L
#undef PG8_BAR
#undef PG8_SCHED
}
}
constexpr int BATCH = 16, SEQ = 2048, DM = 1024, NMETA = 16, NH = 16, HD = 64, DFF = 4096, CW = 31;
constexpr int MR = BATCH * SEQ;
constexpr int MROWS = MR + 256;
constexpr int NIN_SRC = 7184;
constexpr int NIN = 7168;
constexpr float RMS_EPS = 1e-6f, LN_EPS = 1e-5f;
constexpr float LOG2E = 1.4426950408889634f;
constexpr float C2 = 0.125f * LOG2E;

constexpr size_t MiB = 1u << 20;
constexpr size_t WS_SS1 = 0, WS_SS2 = 131072;
constexpr size_t WS_BAR = 524288;
constexpr size_t WS_WIN = 1 * MiB;
constexpr size_t WS_WA = 15 * MiB, WS_WC = 17 * MiB;
constexpr size_t WS_WO2 = 19 * MiB;
constexpr size_t WS_WUP = 23 * MiB;
constexpr size_t WS_WDN = 31 * MiB;
constexpr size_t WS_LOGF = 39 * MiB;
constexpr size_t ACT_R = (size_t)MROWS * 1024 * 2;
constexpr size_t WS_XN = 42 * MiB;
constexpr size_t WS_Q = WS_XN + ACT_R, WS_K = WS_Q + ACT_R, WS_V = WS_K + ACT_R, WS_U = WS_V + ACT_R, WS_GA = WS_U + ACT_R, WS_GC = WS_GA + ACT_R;
constexpr size_t WS_END = WS_GC + ACT_R;
constexpr size_t WS_MM = WS_K;
constexpr size_t WS_H = WS_Q;
static_assert((size_t)MR * 2048 * 2 <= 2 * ACT_R && (size_t)MR * 4096 * 2 <= 4 * ACT_R, "overlays");
static_assert(WS_LOGF + (size_t)MROWS * 64 <= WS_XN, "logf fits");

constexpr int LDS_BYTES = 147456;
constexpr int NWAVES = 8;

#define LAS __attribute__((address_space(3)))
typedef unsigned short bf16;
typedef float f32x4 __attribute__((ext_vector_type(4)));
typedef float f32x2 __attribute__((ext_vector_type(2)));
typedef float f32x16 __attribute__((ext_vector_type(16)));
typedef short bf16x8 __attribute__((ext_vector_type(8)));
typedef short s16x4 __attribute__((ext_vector_type(4)));
typedef unsigned u32x4 __attribute__((ext_vector_type(4)));
typedef unsigned u32x2 __attribute__((ext_vector_type(2)));
using pg8::cvt_pk_bf16;
using pg8::sigmoid_f;

__device__ __forceinline__ float wave_sum(float v) {
#pragma unroll
    for (int o = 1; o < 64; o <<= 1) v += __shfl_xor(v, o);
    return v;
}

__device__ __forceinline__ void transpose_item(const float* W, int ldw, int k0, int srcc0, bf16* WT, int ldt, int dstr0, int dup, LAS float* scr, int lane) {
#pragma unroll 8
    for (int i = 0; i < 32; ++i) { const int kk = 2 * i + (lane >> 5); scr[kk * 33 + (lane & 31)] = W[(size_t)(k0 + kk) * ldw + srcc0 + (lane & 31)]; }
    asm volatile("s_waitcnt lgkmcnt(0)" ::: "memory");
    const int c = lane & 7;
#pragma unroll
    for (int j = 0; j < 4; ++j) { const int n = (lane >> 3) + 8 * j; const LAS float* s = scr + (8 * c) * 33 + n;
        u32x4 o; o.x = cvt_pk_bf16(s[0 * 33], s[1 * 33]); o.y = cvt_pk_bf16(s[2 * 33], s[3 * 33]); o.z = cvt_pk_bf16(s[4 * 33], s[5 * 33]); o.w = cvt_pk_bf16(s[6 * 33], s[7 * 33]);
        bf16* dst = WT + (size_t)(dstr0 + n) * ldt + k0 + 8 * c;
        *(u32x4*)dst = o; if (dup) *(u32x4*)(dst + dup) = o; }
    asm volatile("s_waitcnt lgkmcnt(0)" ::: "memory");
}
__device__ __forceinline__ int win_src_col(int n) {
    if (n < 3072) return n;
    if (n < 5120) { const int j = (n - 3072) >> 8, r = (n - 3072) & 255; return 3088 + (r < 128 ? 128 * j + r : 1024 + 128 * j + (r - 128)); }
    return n + 16;
}

struct Ptrs {
    const float *x, *meta, *g_mix, *w_in, *b_forget, *w_attn_out, *b_glu, *conv_w, *conv_b, *ln_g, *ln_b, *w_conv_out, *b_conv_out, *w_out, *g_mlp, *w_up, *w_down, *g_final;
    float* out; unsigned char* ws;
};

__device__ __forceinline__ void p0_prologue(const Ptrs& P, LAS unsigned char* lds, int bid, int G) {
    int tid = threadIdx.x; asm volatile("" : "+v"(tid)); const int lane = tid & 63, wave = __builtin_amdgcn_readfirstlane(tid >> 6);
    LAS float* scr = (LAS float*)(lds + wave * 8704);
    LAS float* wfg = (LAS float*)(lds + 69632);
    unsigned char* ws = P.ws;
    const int gw = bid * NWAVES + wave, NGW = G * NWAVES;
    for (int idx = tid; idx < 16 * 1024; idx += NWAVES * 64) { const int k = idx >> 4, h = idx & 15; wfg[h * 1024 + k] = P.w_in[(size_t)k * NIN_SRC + 3072 + h]; }
    { float* ss = (float*)(ws + WS_SS1); for (int i = bid * 512 + tid; i < 2 * MR; i += G * 512) ss[i] = 0.f; }
    constexpr int I_IN = 16 * (NIN / 32), I_SQ = 16 * 32, I_UP = 16 * 128, I_DN = 64 * 32;
    constexpr int NITEMS = I_IN + 3 * I_SQ + I_UP + I_DN;
    for (int it = gw; it < NITEMS; it += NGW) {
        int r = it;
        if (r < I_IN) { const int nb = r % (NIN / 32), kb = r / (NIN / 32); transpose_item(P.w_in, NIN_SRC, 64 * kb, win_src_col(32 * nb), (bf16*)(ws + WS_WIN), 1024, 32 * nb, 0, scr, lane); continue; } r -= I_IN;
        if (r < I_SQ) { const int nb = r % 32, kb = r / 32; transpose_item(P.w_attn_out, 1024, 64 * kb, 32 * nb, (bf16*)(ws + WS_WA), 1024, 32 * nb, 0, scr, lane); continue; } r -= I_SQ;
        if (r < I_SQ) { const int nb = r % 32, kb = r / 32; transpose_item(P.w_conv_out, 1024, 64 * kb, 32 * nb, (bf16*)(ws + WS_WC), 1024, 32 * nb, 0, scr, lane); continue; } r -= I_SQ;
        if (r < I_SQ) { const int nb = r % 32, kb = r / 32; transpose_item(P.w_out, 1024, 64 * kb, 32 * nb, (bf16*)(ws + WS_WO2), 2048, 32 * nb, 1024, scr, lane); continue; } r -= I_SQ;
        if (r < I_UP) { const int nb = r % 128, kb = r / 128; transpose_item(P.w_up, 4096, 64 * kb, 32 * nb, (bf16*)(ws + WS_WUP), 1024, 32 * nb, 0, scr, lane); continue; } r -= I_UP;
        { const int nb = r % 32, kb = r / 32; transpose_item(P.w_down, 1024, 64 * kb, 32 * nb, (bf16*)(ws + WS_WDN), 4096, 32 * nb, 0, scr, lane); }
    }
    __syncthreads();
    bf16* XN = (bf16*)(ws + WS_XN); float* logf = (float*)(ws + WS_LOGF);
    f32x4 gq[4];
#pragma unroll
    for (int j = 0; j < 4; ++j) gq[j] = *((const f32x4*)P.g_mix + lane + 64 * j);
    const int hsel = ((lane >> 5) & 1) * 8 + ((lane >> 4) & 1) * 4 + ((lane >> 3) & 1) * 2 + ((lane >> 2) & 1);
    const float bfg = P.b_forget[hsel];
    for (int m = gw; m < MROWS; m += NGW) {
        u32x2* o8 = (u32x2*)(XN + (size_t)m * 1024) + lane;
        if (m >= MR + NMETA) {
#pragma unroll
            for (int j = 0; j < 4; ++j) o8[64 * j] = (u32x2){0u, 0u};
            continue;
        }
        const float* src = (m < MR) ? P.x + (size_t)m * 1024 : P.meta + (size_t)(m - MR) * 1024;
        f32x4 v[4]; float s2 = 0.f;
#pragma unroll
        for (int j = 0; j < 4; ++j) { v[j] = *((const f32x4*)src + lane + 64 * j); s2 += (v[j].x * v[j].x + v[j].y * v[j].y) + (v[j].z * v[j].z + v[j].w * v[j].w); }
        const float rstd = 1.0f / sqrtf(wave_sum(s2) * (1.0f / 1024.0f) + RMS_EPS);
#pragma unroll
        for (int j = 0; j < 4; ++j) { v[j] = v[j] * rstd * gq[j]; u32x2 w; w.x = cvt_pk_bf16(v[j].x, v[j].y); w.y = cvt_pk_bf16(v[j].z, v[j].w); o8[64 * j] = w; }
        float p[16];
#pragma unroll
        for (int h = 0; h < 16; ++h) { float a = 0.f;
#pragma unroll
            for (int j = 0; j < 4; ++j) { const f32x4 w = *((const LAS f32x4*)(wfg + h * 1024) + lane + 64 * j); a += (v[j].x * w.x + v[j].y * w.y) + (v[j].z * w.z + v[j].w * w.w); }
            p[h] = a; }
#pragma unroll
        for (int i = 0; i < 8; ++i) { const bool up = (lane & 32) != 0; const float mine = up ? p[i + 8] : p[i], other = up ? p[i] : p[i + 8]; p[i] = mine + __shfl_xor(other, 32); }
#pragma unroll
        for (int i = 0; i < 4; ++i) { const bool up = (lane & 16) != 0; const float mine = up ? p[i + 4] : p[i], other = up ? p[i] : p[i + 4]; p[i] = mine + __shfl_xor(other, 16); }
#pragma unroll
        for (int i = 0; i < 2; ++i) { const bool up = (lane & 8) != 0; const float mine = up ? p[i + 2] : p[i], other = up ? p[i] : p[i + 2]; p[i] = mine + __shfl_xor(other, 8); }
        { const bool up = (lane & 4) != 0; const float mine = up ? p[1] : p[0], other = up ? p[0] : p[1]; p[0] = mine + __shfl_xor(other, 4); }
        float tot = p[0]; tot += __shfl_xor(tot, 2); tot += __shfl_xor(tot, 1);
        if ((lane & 3) == 0) { const float z = tot + bfg; logf[(size_t)m * 16 + hsel] = fminf(z, 0.f) - log1pf(expf(-fabsf(z))); }
    }
}

namespace att {
constexpr int KS = 144, VS = 192;
constexpr int L_K = 0, L_V = 2 * 64 * KS, L_CUM = L_V + 2 * 64 * VS, L_WS = L_CUM + 2304 * 4, L_OST = L_WS + 8 * 256, L_END = L_OST + 8 * 4096;
static_assert(L_END <= 131072, "attention LDS");
constexpr float NEG = -1.0e30f;
__device__ __forceinline__ s16x4 vtr(const LAS unsigned char* p) { typedef short v4i16_t __attribute__((ext_vector_type(4))); return __builtin_bit_cast(s16x4, __builtin_amdgcn_ds_read_tr16_b64_v4i16((LAS v4i16_t*)p)); }

__device__ __forceinline__ void attn_bh(LAS unsigned char* lds, int bh, bf16* QO, const bf16* Kg, const bf16* Vg, const float* logf) {
    int tid = threadIdx.x; asm volatile("" : "+v"(tid)); const int lane = tid & 63, wid = __builtin_amdgcn_readfirstlane(tid >> 6);
    const int b = bh >> 4, h = bh & 15, r32 = lane & 31, hi = lane >> 5;
    LAS float* cum = (LAS float*)(lds + L_CUM);
    LAS float* wsc = (LAS float*)(lds + L_WS) + wid * 64;
    LAS bf16* stg = (LAS bf16*)(lds + L_OST) + wid * 2048;
    {
        LAS float* wtot = (LAS float*)(lds + L_WS);
        float mv = (lane < 16) ? logf[(size_t)(MR + lane) * 16 + h] : 0.f;
#pragma unroll
        for (int d = 1; d < 16; d <<= 1) { const float y = __shfl_up(mv, d); if (lane >= d) mv += y; }
        const float metaTot = __shfl(mv, 15);
        if (wid == 0 && lane < 16) cum[lane] = mv * LOG2E;
        const float* lf = logf + ((size_t)b * SEQ + 4 * tid) * 16 + h;
        const float a0 = lf[0], a1 = a0 + lf[16], a2 = a1 + lf[32], a3 = a2 + lf[48];
        float xs = a3;
#pragma unroll
        for (int d = 1; d < 64; d <<= 1) { const float y = __shfl_up(xs, d); if (lane >= d) xs += y; }
        if (lane == 63) wtot[wid] = xs;
        __syncthreads();
        float off = metaTot + (xs - a3);
        for (int w = 0; w < wid; ++w) off += wtot[w];
        *(LAS f32x4*)(cum + 16 + 4 * tid) = (f32x4){(off + a0) * LOG2E, (off + a1) * LOG2E, (off + a2) * LOG2E, (off + a3) * LOG2E};
        __syncthreads();
    }
    const size_t rowb = (size_t)b * SEQ;
    const int ldrow = tid >> 3, ldch = tid & 7;
    const int vlane = ((lane >> 4) & 1) * 32 + (lane & 3) * 8 + (4 * hi + ((lane & 15) >> 2)) * VS;
    for (int qb = 0; qb < SEQ / 256; ++qb) {
        const int q0 = qb * 256 + wid * 32, qpos = q0 + r32;
        bf16* Qw = QO + (rowb + qpos) * 1024 + h * 64;
        bf16x8 qr[4];
#pragma unroll
        for (int d0 = 0; d0 < 4; ++d0) qr[d0] = *(const bf16x8*)(Qw + d0 * 16 + hi * 8);
        const float cq = cum[16 + qpos];
        float mrun = NEG, lrun = 0.f; f32x16 o0, o1;
#pragma unroll
        for (int r = 0; r < 16; ++r) { o0[r] = 0.f; o1[r] = 0.f; }
        const int NT = 4 * qb + 5, ti_max = 4 * qb + (wid >> 1) + 1;
        u32x4 kreg, vreg;
        if (ldrow < NMETA) { kreg = *(const u32x4*)(Kg + (size_t)(MR + ldrow) * 1024 + h * 64 + ldch * 8); vreg = *(const u32x4*)(Vg + (size_t)(MR + ldrow) * 1024 + h * 64 + ldch * 8); }
        else { kreg = (u32x4){0u, 0u, 0u, 0u}; vreg = kreg; }
        *(LAS u32x4*)(lds + L_K + ldrow * KS + ldch * 16) = kreg; *(LAS u32x4*)(lds + L_V + ldrow * VS + ldch * 16) = vreg;
        __syncthreads();
        for (int ti = 0; ti < NT; ++ti) {
            if (ti + 1 < NT) { const size_t gr = (rowb + 64 * ti + ldrow) * 1024 + h * 64 + ldch * 8; kreg = *(const u32x4*)(Kg + gr); vreg = *(const u32x4*)(Vg + gr); }
            if (ti <= ti_max) {
                const LAS unsigned char* Kb = lds + L_K + (ti & 1) * 64 * KS; const LAS unsigned char* Vb = lds + L_V + (ti & 1) * 64 * VS;
                f32x16 p0, p1;
#pragma unroll
                for (int r = 0; r < 16; ++r) { p0[r] = 0.f; p1[r] = 0.f; }
#pragma unroll
                for (int d0 = 0; d0 < 4; ++d0) {
                    const bf16x8 ka = *(const LAS bf16x8*)(Kb + r32 * KS + d0 * 32 + hi * 16);
                    const bf16x8 kb2 = *(const LAS bf16x8*)(Kb + (32 + r32) * KS + d0 * 32 + hi * 16);
                    p0 = __builtin_amdgcn_mfma_f32_32x32x16_bf16(ka, qr[d0], p0, 0, 0, 0);
                    p1 = __builtin_amdgcn_mfma_f32_32x32x16_bf16(kb2, qr[d0], p1, 0, 0, 0);
                }
                const int tb = (ti == 0) ? 0 : 16 + 64 * (ti - 1);
#pragma unroll
                for (int g = 0; g < 4; ++g) { const f32x4 c0 = *(const LAS f32x4*)(cum + tb + 8 * g + 4 * hi), c1 = *(const LAS f32x4*)(cum + tb + 32 + 8 * g + 4 * hi);
#pragma unroll
                    for (int e = 0; e < 4; ++e) { p0[4 * g + e] += cq - c0[e]; p1[4 * g + e] += cq - c1[e]; } }
                if (ti == 0) {
#pragma unroll
                    for (int r = 0; r < 16; ++r) { if (r >= 8) p0[r] = NEG; p1[r] = NEG; }
                } else if (ti == ti_max) {
                    const int kb0 = 64 * (ti - 1) + 4 * hi;
#pragma unroll
                    for (int r = 0; r < 16; ++r) { const int kv = kb0 + (r & 3) + 8 * (r >> 2); if (kv > qpos) p0[r] = NEG; if (kv + 32 > qpos) p1[r] = NEG; }
                }
                float mx = fmaxf(p0[0], p1[0]);
#pragma unroll
                for (int r = 1; r < 16; ++r) mx = fmaxf(mx, fmaxf(p0[r], p1[r]));
                mx = fmaxf(mx, __shfl_xor(mx, 32));
                const float mn = fmaxf(mrun, mx), alpha = __builtin_amdgcn_exp2f(mrun - mn); mrun = mn;
                float rs = 0.f;
#pragma unroll
                for (int r = 0; r < 16; ++r) { p0[r] = __builtin_amdgcn_exp2f(p0[r] - mn); p1[r] = __builtin_amdgcn_exp2f(p1[r] - mn); rs += p0[r] + p1[r]; }
                lrun = lrun * alpha + rs;
                if (__any(alpha != 1.0f)) {
                    if (hi == 0) wsc[r32] = alpha;
#pragma unroll
                    for (int g = 0; g < 4; ++g) { const f32x4 a = *(const LAS f32x4*)(wsc + 8 * g + 4 * hi);
#pragma unroll
                        for (int e = 0; e < 4; ++e) { o0[4 * g + e] *= a[e]; o1[4 * g + e] *= a[e]; } }
                }
                bf16x8 pw[4];
                { u32x4 w;
                  w.x = cvt_pk_bf16(p0[0], p0[1]); w.y = cvt_pk_bf16(p0[2], p0[3]); w.z = cvt_pk_bf16(p0[4], p0[5]); w.w = cvt_pk_bf16(p0[6], p0[7]); pw[0] = __builtin_bit_cast(bf16x8, w);
                  w.x = cvt_pk_bf16(p0[8], p0[9]); w.y = cvt_pk_bf16(p0[10], p0[11]); w.z = cvt_pk_bf16(p0[12], p0[13]); w.w = cvt_pk_bf16(p0[14], p0[15]); pw[1] = __builtin_bit_cast(bf16x8, w);
                  w.x = cvt_pk_bf16(p1[0], p1[1]); w.y = cvt_pk_bf16(p1[2], p1[3]); w.z = cvt_pk_bf16(p1[4], p1[5]); w.w = cvt_pk_bf16(p1[6], p1[7]); pw[2] = __builtin_bit_cast(bf16x8, w);
                  w.x = cvt_pk_bf16(p1[8], p1[9]); w.y = cvt_pk_bf16(p1[10], p1[11]); w.z = cvt_pk_bf16(p1[12], p1[13]); w.w = cvt_pk_bf16(p1[14], p1[15]); pw[3] = __builtin_bit_cast(bf16x8, w); }
#pragma unroll
                for (int j = 0; j < 4; ++j) {
                    const LAS unsigned char* vp = Vb + vlane + 16 * j * VS;
                    const s16x4 a0 = vtr(vp), a1 = vtr(vp + 8 * VS), b0 = vtr(vp + 64), b1 = vtr(vp + 8 * VS + 64);
                    const bf16x8 vf0 = (bf16x8){a0[0], a0[1], a0[2], a0[3], a1[0], a1[1], a1[2], a1[3]};
                    const bf16x8 vf1 = (bf16x8){b0[0], b0[1], b0[2], b0[3], b1[0], b1[1], b1[2], b1[3]};
                    o0 = __builtin_amdgcn_mfma_f32_32x32x16_bf16(pw[j], vf0, o0, 0, 0, 0);
                    o1 = __builtin_amdgcn_mfma_f32_32x32x16_bf16(pw[j], vf1, o1, 0, 0, 0);
                }
            }
            if (ti + 1 < NT) { const int nb = (ti + 1) & 1; *(LAS u32x4*)(lds + L_K + nb * 64 * KS + ldrow * KS + ldch * 16) = kreg; *(LAS u32x4*)(lds + L_V + nb * 64 * VS + ldrow * VS + ldch * 16) = vreg; }
            __syncthreads();
        }
        lrun += __shfl_xor(lrun, 32);
        if (hi == 0) wsc[32 + r32] = 1.0f / lrun;
#pragma unroll
        for (int g = 0; g < 4; ++g) { const f32x4 il = *(const LAS f32x4*)(wsc + 32 + 8 * g + 4 * hi);
#pragma unroll
            for (int e = 0; e < 4; ++e) { const int r = 4 * g + e, orow = 8 * g + 4 * hi + e;
                stg[orow * 64 + r32] = (bf16)(cvt_pk_bf16(o0[r] * il[e], 0.f) & 0xffffu);
                stg[orow * 64 + 32 + r32] = (bf16)(cvt_pk_bf16(o1[r] * il[e], 0.f) & 0xffffu); } }
#pragma unroll
        for (int i = 0; i < 4; ++i) { const int row = i * 8 + (lane >> 3), ch = lane & 7; const u32x4 v = *(const LAS u32x4*)(stg + row * 64 + ch * 8);
            *(u32x4*)(QO + (rowb + q0 + row) * 1024 + h * 64 + ch * 8) = v; }
    }
    __syncthreads();
}
}

__device__ __forceinline__ void conv_tile(LAS unsigned char* lds, int tile, const bf16* U, const float* cw, const float* cb, const float* lng, const float* lnb, bf16* OUT) {
    int tid = threadIdx.x; asm volatile("" : "+v"(tid)); const int lane = tid & 63, wid = __builtin_amdgcn_readfirstlane(tid >> 6);
    const int b = tile >> 4, s0 = (tile & 15) * 128, ch = 2 * tid;
    LAS float* ct = (LAS float*)lds;
    f32x2 w[CW];
#pragma unroll
    for (int j = 0; j < CW; ++j) w[j] = *(const f32x2*)(cw + j * 1024 + ch);
    const f32x2 bias = *(const f32x2*)(cb + ch);
    f32x2 win[46];
    const unsigned* U32 = (const unsigned*)U;
#pragma unroll
    for (int i = 0; i < 30; ++i) {
        unsigned v = 0u;
        if (s0 == 0) { if (i >= 14) v = U32[(size_t)(MR + i - 14) * 512 + tid]; }
        else v = U32[((size_t)b * SEQ + s0 - 30 + i) * 512 + tid];
        win[i] = (f32x2){pg8::bf_lo(v), pg8::bf_hi(v)};
    }
#pragma unroll 1
    for (int chunk = 0; chunk < 8; ++chunk) {
        const size_t rbase = (size_t)b * SEQ + s0 + chunk * 16;
#pragma unroll
        for (int i = 0; i < 16; ++i) { const unsigned v = U32[(rbase + i) * 512 + tid]; win[30 + i] = (f32x2){pg8::bf_lo(v), pg8::bf_hi(v)}; }
#pragma unroll
        for (int i = 0; i < 16; ++i) {
            f32x2 a = bias;
#pragma unroll
            for (int j = 0; j < CW; ++j) a = __builtin_elementwise_fma(w[j], win[i + j], a);
            *(LAS f32x2*)(ct + i * 1024 + ch) = a;
        }
#pragma unroll
        for (int i = 0; i < 30; ++i) win[i] = win[i + 16];
        __syncthreads();
#pragma unroll 1
        for (int rr = 0; rr < 2; ++rr) {
            const int row = 2 * wid + rr;
            f32x4 x[4]; float s = 0.f;
#pragma unroll
            for (int j = 0; j < 4; ++j) { x[j] = *((const LAS f32x4*)(ct + row * 1024) + lane + 64 * j); s += (x[j].x + x[j].y) + (x[j].z + x[j].w); }
            const float mean = wave_sum(s) * (1.0f / 1024.0f); float q = 0.f;
#pragma unroll
            for (int j = 0; j < 4; ++j) { x[j] = x[j] - mean; q += (x[j].x * x[j].x + x[j].y * x[j].y) + (x[j].z * x[j].z + x[j].w * x[j].w); }
            const float rstd = 1.0f / sqrtf(wave_sum(q) * (1.0f / 1024.0f) + LN_EPS);
            u32x2* o8 = (u32x2*)(OUT + (rbase + row) * 1024) + lane;
#pragma unroll
            for (int j = 0; j < 4; ++j) { const f32x4 g = *((const f32x4*)lng + lane + 64 * j), bb = *((const f32x4*)lnb + lane + 64 * j);
                f32x4 y = x[j] * rstd * g + bb;
#pragma unroll
                for (int e = 0; e < 4; ++e) y[e] = y[e] * sigmoid_f(y[e]);
                u32x2 wv; wv.x = cvt_pk_bf16(y.x, y.y); wv.y = cvt_pk_bf16(y.z, y.w); o8[64 * j] = wv; }
        }
        __syncthreads();
    }
}

#define XB_TMO      128
#define XB_XCNT(j)  (256  + 64 * (j))
#define XB_XSUB(j)  (1280 + 64 * (j))
#define XB_XGEN(j)  (2304 + 64 * (j))
#define XB_TOP      3328
#define XB_TOPGEN   3392
#define XCD_BAR_WORDS 3456
#define XB_SPIN_CAP (1u << 18)

__device__ __forceinline__ unsigned xb_ld(unsigned* p)              { return __hip_atomic_load(p, __ATOMIC_RELAXED, __HIP_MEMORY_SCOPE_AGENT); }
__device__ __forceinline__ unsigned xb_add(unsigned* p, unsigned v) { return __hip_atomic_fetch_add(p, v, __ATOMIC_RELAXED, __HIP_MEMORY_SCOPE_AGENT); }
__device__ __forceinline__ unsigned xb_xcc_id() { return (unsigned)__builtin_amdgcn_s_getreg((3 << 11) | 20) & 0xFu; }
#define XB_SPIN(cond, bar) do { unsigned _sp = 0; while (cond) { __builtin_amdgcn_s_sleep(1); \
    if ((++_sp & 255u) == 0u) { if (xb_ld(&(bar)[XB_TMO])) break; if (_sp > XB_SPIN_CAP) { atomicAdd(&(bar)[XB_TMO], 1u); break; } } } } while (0)

struct XcdBarrier {
    unsigned* bar; unsigned x;
    volatile LAS unsigned* st;
};

__device__ __forceinline__ XcdBarrier xcd_barrier_post(unsigned* bar, volatile LAS unsigned* st) {
    XcdBarrier b; b.bar = bar; b.x = xb_xcc_id(); b.st = st;
    if (threadIdx.x == 0) (void)xb_add(&bar[XB_XCNT(b.x)], 1u);
    return b;
}
__device__ __forceinline__ void xcd_barrier_complete(unsigned* bar, unsigned x, unsigned& nloc, unsigned& nx) {
    const unsigned G = gridDim.x * gridDim.y * gridDim.z;
    unsigned sum, cnt, mine, sp = 0u;
    for (;;) {
        sum = 0u; cnt = 0u; mine = 0u;
#pragma unroll
        for (unsigned j = 0; j < 16; ++j) { const unsigned c = xb_ld(&bar[XB_XCNT(j)]); sum += c; cnt += (c > 0u) ? 1u : 0u; mine = (j == x) ? c : mine; }
        if (sum == G) break;
        __builtin_amdgcn_s_sleep(1);
        if ((++sp & 255u) == 0u) { if (xb_ld(&bar[XB_TMO])) break; if (sp > XB_SPIN_CAP) { atomicAdd(&bar[XB_TMO], 1u); break; } }
    }
    nloc = mine > 0u ? mine : 1u; nx = cnt > 0u ? cnt : 1u;
}

__device__ __forceinline__ void xcd_barrier(const XcdBarrier& b) {
    asm volatile("s_waitcnt vmcnt(0)" ::: "memory");
    __syncthreads();
    if (threadIdx.x == 0) {
        unsigned* bar = b.bar;
        __builtin_amdgcn_s_waitcnt(0);
        unsigned nloc = b.st[0], nx = b.st[1];
        if (nloc == 0u) { xcd_barrier_complete(bar, b.x, nloc, nx); b.st[0] = nloc; b.st[1] = nx; }
        const unsigned old = xb_add(&bar[XB_XSUB(b.x)], 1u);
        const unsigned gen = old / nloc;
        if (old + 1u == (gen + 1u) * nloc) {
            __builtin_amdgcn_fence(__ATOMIC_RELEASE, "agent");
            asm volatile("s_waitcnt vmcnt(0)" ::: "memory");
            const unsigned og = xb_add(&bar[XB_TOP], 1u);
            const unsigned tg = og / nx;
            if (og + 1u == (tg + 1u) * nx) xb_add(&bar[XB_TOPGEN], 1u);
            else XB_SPIN(xb_ld(&bar[XB_TOPGEN]) == tg, bar);
            __builtin_amdgcn_fence(__ATOMIC_ACQUIRE, "agent");
            xb_add(&bar[XB_XGEN(b.x)], 1u);
            asm volatile("s_waitcnt vmcnt(0)" ::: "memory");
        } else {
            XB_SPIN(xb_ld(&bar[XB_XGEN(b.x)]) == gen, bar);
            __builtin_amdgcn_fence(__ATOMIC_ACQUIRE, "agent");
            asm volatile("s_waitcnt vmcnt(0)" ::: "memory");
        }
    }
    __syncthreads();
}

__global__ void __launch_bounds__(NWAVES * 64, 2) fox_fwd(Ptrs P) {
    extern __shared__ __attribute__((aligned(16))) unsigned char lds_raw[];
    LAS unsigned char* lds = (LAS unsigned char*)lds_raw;
    cg::grid_group grid = cg::this_grid();
    const int bid = blockIdx.x, G = gridDim.x;
    unsigned char* ws = P.ws;
    bf16* XN = (bf16*)(ws + WS_XN); bf16* Qb = (bf16*)(ws + WS_Q); bf16* Kb = (bf16*)(ws + WS_K); bf16* Vb = (bf16*)(ws + WS_V); bf16* Ub = (bf16*)(ws + WS_U);
    bf16* GA = (bf16*)(ws + WS_GA); bf16* GC = (bf16*)(ws + WS_GC); bf16* MM = (bf16*)(ws + WS_MM); bf16* Hb = (bf16*)(ws + WS_H);
    float* ss1 = (float*)(ws + WS_SS1); float* ss2 = (float*)(ws + WS_SS2); float* logf = (float*)(ws + WS_LOGF);

    volatile LAS unsigned* bst = (volatile LAS unsigned*)(lds + 140000);
    if (threadIdx.x == 0) { bst[0] = 0u; bst[1] = 0u; }
    if (bid == 0) { unsigned* bw = (unsigned*)(ws + WS_BAR); for (int i = threadIdx.x; i < XCD_BAR_WORDS; i += NWAVES * 64) bw[i] = 0u; }
    p0_prologue(P, lds, bid, G);
    grid.sync();
    const XcdBarrier xbar = xcd_barrier_post((unsigned*)(ws + WS_BAR), bst);
    {
        pg8::GemmPlain g{XN, (const bf16*)(ws + WS_WIN), 1024}; pg8::InProjOrder S; S.init(MR, NIN, G, bid);
        pg8::EpiInProj E{Qb, Kb, Vb, Ub, GA, GC, P.b_glu, C2};
        pg8::gemm_phase<pg8::EpiInProj, pg8::InProjOrder, pg8::GemmPlain, true, true>(lds, g, S, E);
    }
    xcd_barrier(xbar);
    for (int bh = bid; bh < BATCH * NH; bh += G) att::attn_bh(lds, bh, Qb, Kb, Vb, logf);
    for (int t = bid; t < MR / 128; t += G) conv_tile(lds, t, Ub, P.conv_w, P.conv_b, P.ln_g, P.ln_b, XN);
    xcd_barrier(xbar);
    {
        pg8::GemmBranch g{Qb, XN, (const bf16*)(ws + WS_WA), (const bf16*)(ws + WS_WC), 1024}; pg8::StaticOrder S; S.init(MR, 2048, G, bid);
        pg8::EpiBranch E{MM, GA, GC, P.b_conv_out};
        pg8::gemm_phase<pg8::EpiBranch, pg8::StaticOrder, pg8::GemmBranch, true, true>(lds, g, S, E);
    }
    xcd_barrier(xbar);
    {
        pg8::GemmPlain g{MM, (const bf16*)(ws + WS_WO2), 2048}; pg8::StaticOrder S; S.init(MR, 1024, G, bid);
        pg8::EpiResid<true> E{P.x, P.out, ss1, XN, P.g_mlp};
        pg8::gemm_phase<pg8::EpiResid<true>, pg8::StaticOrder, pg8::GemmPlain, true, true>(lds, g, S, E);
    }
    xcd_barrier(xbar);
    {
        pg8::GemmPlain g{XN, (const bf16*)(ws + WS_WUP), 1024}; pg8::StaticOrder S; S.init(MR, DFF, G, bid);
        pg8::EpiUp E{Hb, ss1, RMS_EPS};
        pg8::gemm_phase<pg8::EpiUp, pg8::StaticOrder, pg8::GemmPlain, true, true>(lds, g, S, E);
    }
    xcd_barrier(xbar);
    {
        pg8::GemmPlain g{Hb, (const bf16*)(ws + WS_WDN), DFF}; pg8::StaticOrder S; S.init(MR, 1024, G, bid);
        pg8::EpiResid<false> E{P.out, P.out, ss2, nullptr, nullptr};
        pg8::gemm_phase<pg8::EpiResid<false>, pg8::StaticOrder, pg8::GemmPlain, true, true>(lds, g, S, E);
    }
    xcd_barrier(xbar);
    {
        int tid = threadIdx.x; asm volatile("" : "+v"(tid)); const int lane = tid & 63, wave = __builtin_amdgcn_readfirstlane(tid >> 6);
        const int gw = bid * NWAVES + wave, NGW = G * NWAVES;
        f32x4 gf[4];
#pragma unroll
        for (int j = 0; j < 4; ++j) gf[j] = *((const f32x4*)P.g_final + lane + 64 * j);
        for (int m = gw; m < MR; m += NGW) {
            f32x4* row = (f32x4*)(P.out + (size_t)m * 1024) + lane; const float rstd = 1.0f / sqrtf(ss2[m] * (1.0f / 1024.0f) + RMS_EPS);
#pragma unroll
            for (int j = 0; j < 4; ++j) row[64 * j] = row[64 * j] * rstd * gf[j];
        }
    }
}

extern "C" void kernel_launch(void* const* d_in, const int* in_sizes, int n_in, void* d_out, int out_size, void* d_ws, size_t ws_size, hipStream_t stream) {
    static int grid = 0;
    if (grid == 0) {
        if (n_in != 18 || in_sizes[0] != MR * DM || out_size != MR * DM || ws_size < WS_END) { fprintf(stderr, "kernel_launch: unexpected shapes (n_in %d, in0 %d, out %d, ws %zu need %zu)\n", n_in, n_in > 0 ? in_sizes[0] : -1, out_size, ws_size, (size_t)WS_END); grid = -1; return; }
        int dev = 0, cus = 0, per_cu = 0;
        if (hipGetDevice(&dev) != hipSuccess || hipDeviceGetAttribute(&cus, hipDeviceAttributeMultiprocessorCount, dev) != hipSuccess) { grid = -1; return; }
        if (hipFuncSetAttribute((const void*)fox_fwd, hipFuncAttributeMaxDynamicSharedMemorySize, LDS_BYTES) != hipSuccess) { fprintf(stderr, "kernel_launch: hipFuncSetAttribute failed\n"); grid = -1; return; }
        if (hipOccupancyMaxActiveBlocksPerMultiprocessor(&per_cu, (const void*)fox_fwd, NWAVES * 64, LDS_BYTES) != hipSuccess || per_cu < 1) { fprintf(stderr, "kernel_launch: occupancy query failed (%d)\n", per_cu); (void)hipGetLastError(); per_cu = 1; }
        grid = cus * (per_cu > 1 ? 1 : per_cu);
        if (grid > 256) grid = 256;
    }
    if (grid < 0) return;
    Ptrs p{};
    const float** f = (const float**)&p;
    for (int i = 0; i < 18; ++i) f[i] = (const float*)d_in[i];
    p.out = (float*)d_out; p.ws = (unsigned char*)d_ws;
    void* args[] = {&p};
    hipError_t e = hipLaunchCooperativeKernel((const void*)fox_fwd, dim3(grid), dim3(NWAVES * 64), args, LDS_BYTES, stream);
    if (e != hipSuccess) fprintf(stderr, "kernel_launch: cooperative launch failed: %s (grid %d)\n", hipGetErrorString(e), grid);
}
```
